# Optimizing an MI355X kernel written in HIP

```python
import math
import jax
import jax.numpy as jnp
from jax import lax
import numpy as np

D_MODEL = 1024
BATCH = 16
SEQ = 2048
DEPTH = 1
DEC_BATCH = 16
DEC_SEQ = 32
PAST_LEN = 4096

CHUNK = 64
Q_BLOCK = 128
A_HEADS = 8
A_DIM = 64
A_VDIM = 2 * A_DIM
B_HEADS = 8
B_DK = 128
B_DV = 128
CONV_W = 4
DELTA_BLOCK = 64
D_FF = -(-8 * D_MODEL // (3 * 256)) * 256
EPS = 1e-6

A_QK = A_HEADS * 2 * A_DIM
A_V = A_HEADS * A_VDIM
B_QK = B_HEADS * B_DK
B_V = B_HEADS * B_DV
CONV_CH = 2 * B_QK + B_V
IN_WIDTHS = (A_QK, A_QK, A_V, CONV_CH, B_V, B_HEADS, B_HEADS, D_MODEL, D_MODEL)
IN_SPLITS = tuple(sum(IN_WIDTHS[:i + 1]) for i in range(len(IN_WIDTHS) - 1))
D_IN = sum(IN_WIDTHS)

kernel_name = 'diffattn_gdn_gated_hybrid_stream_step'


def rms_norm(x, w):
    xf = x.astype(jnp.float32)
    y = xf * lax.rsqrt(jnp.mean(xf * xf, axis=-1, keepdims=True) + EPS)
    return (y * w.astype(jnp.float32)).astype(x.dtype)


def l2_norm(x):
    xf = x.astype(jnp.float32)
    return xf * lax.rsqrt(jnp.sum(xf * xf, axis=-1, keepdims=True) + EPS)


def diff_attn_core(q, k, v, lam, mask):
    s = jnp.einsum('bqhmd,bkhmd->bhmqk', q, k).astype(jnp.float32) * (A_DIM ** -0.5)
    if mask is not None:
        s = jnp.where(mask, s, -jnp.inf)
    p = jax.nn.softmax(s, axis=-1)
    a = p[:, :, 0] - lam * p[:, :, 1]
    return jnp.einsum('bhqk,bkhe->bqhe', a.astype(v.dtype), v)


def diff_attn_prompt(q, k, v, lam):
    bsz, seq = q.shape[:2]
    nb = seq // Q_BLOCK
    q_blocks = jnp.swapaxes(q.reshape(bsz, nb, Q_BLOCK, A_HEADS, 2, A_DIM), 0, 1)
    k_chunk = jnp.arange(seq) // CHUNK

    def one_block(args):
        q_blk, i = args
        q_chunk = (i * Q_BLOCK + jnp.arange(Q_BLOCK)) // CHUNK
        mask = k_chunk[None, :] <= q_chunk[:, None]
        return diff_attn_core(q_blk, k, v, lam, mask)

    o = lax.map(one_block, (q_blocks, jnp.arange(nb)))
    return jnp.swapaxes(o, 0, 1).reshape(bsz, seq, A_HEADS, A_VDIM)


def causal_conv(x, buf, w):
    seq = x.shape[1]
    xpad = jnp.concatenate([buf.astype(x.dtype), x], axis=1)
    y = xpad[:, 0:seq] * w[0]
    for j in range(1, CONV_W):
        y = y + xpad[:, j:j + seq] * w[j]
    return y, xpad[:, -(CONV_W - 1):]


def gated_delta_rule(q, k, v, g, beta, s0):
    bsz, seq, nh, dk = q.shape
    dv = v.shape[-1]
    c = DELTA_BLOCK if seq % DELTA_BLOCK == 0 else seq
    n = seq // c

    def blocks(t):
        t = t.astype(jnp.float32).reshape(bsz, n, c, nh, *t.shape[3:])
        return jnp.swapaxes(t, 2, 3)

    q = blocks(q) * (dk ** -0.5)
    k = blocks(k)
    v = blocks(v)
    g = blocks(g)
    beta = blocks(beta)
    G = jnp.cumsum(g, axis=-1)
    idx = jnp.arange(c)
    causal = idx[:, None] >= idx[None, :]
    strict = idx[:, None] > idx[None, :]
    decay = jnp.exp(jnp.where(causal, G[..., :, None] - G[..., None, :], -jnp.inf))
    kk = jnp.einsum('bnhid,bnhjd->bnhij', k, k)
    m = jnp.where(strict, beta[..., :, None] * kk * decay, 0.0)
    rhs = jnp.concatenate([v * beta[..., None], k * (beta * jnp.exp(G))[..., None]], axis=-1)
    sol = lax.linalg.triangular_solve(m, rhs, left_side=True, lower=True, unit_diagonal=True)
    u, w = sol[..., :dv], sol[..., dv:]
    a_loc = jnp.where(causal, jnp.einsum('bnhid,bnhjd->bnhij', q, k) * decay, 0.0)
    q_dec = q * jnp.exp(G)[..., None]
    k_tail = k * jnp.exp(G[..., -1:] - G)[..., None]
    g_tail = jnp.exp(G[..., -1])

    def step(s, xs):
        u_i, w_i, a_i, qd_i, kt_i, gt_i = xs
        v_new = u_i - jnp.einsum('bhcd,bhde->bhce', w_i, s)
        o_i = jnp.einsum('bhcd,bhde->bhce', qd_i, s) + jnp.einsum('bhij,bhje->bhie', a_i, v_new)
        s = s * gt_i[..., None, None] + jnp.einsum('bhcd,bhce->bhde', kt_i, v_new)
        return s, o_i

    xs = tuple(jnp.moveaxis(t, 1, 0) for t in (u, w, a_loc, q_dec, k_tail, g_tail))
    s_final, o = lax.scan(step, s0.astype(jnp.float32), xs)
    o = jnp.moveaxis(o, 0, 1)
    o = jnp.swapaxes(o, 2, 3).reshape(bsz, seq, nh, dv)
    return o, s_final


def hybrid_layer(x, past_k, past_v, s0, conv_buf, lam_init,
                 ln1_w, w_in, q_norm_w, k_norm_w, lambda_q1, lambda_k1, lambda_q2, lambda_k2,
                 subln_w, w_branch_a, conv_w, a_log, dt_bias, delta_norm_w, w_branch_b,
                 w_out, ln2_w, w_gate_up, w_down):
    f32 = jnp.float32
    bsz, seq, _ = x.shape
    h = rms_norm(x, ln1_w)
    z = h @ w_in
    aq, ak, av, dqkv, dgate, dbeta, dalpha, gate_a, gate_b = jnp.split(z, IN_SPLITS, axis=-1)

    aq = rms_norm(aq.reshape(bsz, seq, A_HEADS, 2, A_DIM), q_norm_w)
    ak = rms_norm(ak.reshape(bsz, seq, A_HEADS, 2, A_DIM), k_norm_w)
    av = av.reshape(bsz, seq, A_HEADS, A_VDIM)
    lam = (jnp.exp(jnp.dot(lambda_q1.astype(f32), lambda_k1.astype(f32)))
           - jnp.exp(jnp.dot(lambda_q2.astype(f32), lambda_k2.astype(f32))) + lam_init)
    if past_k is None:
        o_a = diff_attn_prompt(aq, ak, av, lam)
    else:
        keys = jnp.concatenate([past_k.astype(ak.dtype), ak], axis=1)
        vals = jnp.concatenate([past_v.astype(av.dtype), av], axis=1)
        o_a = diff_attn_core(aq, keys, vals, lam, None)
    o_a = rms_norm(o_a, subln_w) * (1.0 - lam_init)
    branch_a = o_a.reshape(bsz, seq, A_V) @ w_branch_a

    conv, new_conv = causal_conv(dqkv, conv_buf, conv_w)
    conv = jax.nn.silu(conv)
    dq, dk, dv = jnp.split(conv, (B_QK, 2 * B_QK), axis=-1)
    dq = l2_norm(dq.reshape(bsz, seq, B_HEADS, B_DK))
    dk = l2_norm(dk.reshape(bsz, seq, B_HEADS, B_DK))
    dv = dv.reshape(bsz, seq, B_HEADS, B_DV)
    beta = jax.nn.sigmoid(dbeta.astype(f32))
    g = -jnp.exp(a_log.astype(f32)) * jax.nn.softplus(dalpha.astype(f32) + dt_bias.astype(f32))
    o_b, s_new = gated_delta_rule(dq, dk, dv, g, beta, s0)
    o_b = rms_norm(o_b, delta_norm_w) * jax.nn.silu(dgate.reshape(bsz, seq, B_HEADS, B_DV).astype(f32))
    branch_b = o_b.astype(x.dtype).reshape(bsz, seq, B_V) @ w_branch_b

    merged = jax.nn.sigmoid(gate_a) * branch_a + jax.nn.sigmoid(gate_b) * branch_b
    x = x + merged @ w_out

    h2 = rms_norm(x, ln2_w)
    gg, uu = jnp.split(h2 @ w_gate_up, 2, axis=-1)
    x = x + (jax.nn.silu(gg) * uu) @ w_down
    return x, ak, av, s_new, new_conv


def setup_inputs(seed: int = 0) -> dict:
    key = jax.random.key(seed)
    ks = jax.random.split(key, 32)
    f32 = jnp.float32

    def nrm(k, shape, scale):
        return jax.random.normal(k, shape, f32) * scale

    def gain(k, shape):
        return 1.0 + 0.01 * jax.random.normal(k, shape, f32)

    dt = jnp.exp(jax.random.uniform(ks[20], (DEPTH, B_HEADS), f32, math.log(1e-3), math.log(1e-1)))
    return {
        'x_prompt': nrm(ks[0], (BATCH, SEQ, D_MODEL), 1.0),
        'x_sample': nrm(ks[1], (DEC_BATCH, DEC_SEQ, D_MODEL), 1.0),
        'cache_k': nrm(ks[2], (DEPTH, DEC_BATCH, PAST_LEN, A_HEADS, 2, A_DIM), 1.0),
        'cache_v': nrm(ks[3], (DEPTH, DEC_BATCH, PAST_LEN, A_HEADS, A_VDIM), 1.0),
        'state_delta': nrm(ks[4], (DEPTH, DEC_BATCH, B_HEADS, B_DK, B_DV), 0.05),
        'state_conv': nrm(ks[5], (DEPTH, DEC_BATCH, CONV_W - 1, CONV_CH), 1.0),
        'ln1_w': gain(ks[6], (DEPTH, D_MODEL)),
        'w_in': nrm(ks[7], (DEPTH, D_MODEL, D_IN), D_MODEL ** -0.5),
        'q_norm_w': gain(ks[8], (DEPTH, A_DIM)),
        'k_norm_w': gain(ks[9], (DEPTH, A_DIM)),
        'lambda_q1': nrm(ks[10], (DEPTH, A_DIM), 0.1),
        'lambda_k1': nrm(ks[11], (DEPTH, A_DIM), 0.1),
        'lambda_q2': nrm(ks[12], (DEPTH, A_DIM), 0.1),
        'lambda_k2': nrm(ks[13], (DEPTH, A_DIM), 0.1),
        'subln_w': gain(ks[14], (DEPTH, A_VDIM)),
        'w_branch_a': nrm(ks[15], (DEPTH, A_V, D_MODEL), A_V ** -0.5),
        'conv_w': nrm(ks[16], (DEPTH, CONV_W, CONV_CH), CONV_W ** -0.5),
        'a_log': jnp.log(jax.random.uniform(ks[17], (DEPTH, B_HEADS), f32, 1.0, 16.0)),
        'dt_bias': dt + jnp.log(-jnp.expm1(-dt)),
        'delta_norm_w': gain(ks[18], (DEPTH, B_DV)),
        'w_branch_b': nrm(ks[19], (DEPTH, B_V, D_MODEL), B_V ** -0.5),
        'w_out': nrm(ks[21], (DEPTH, D_MODEL, D_MODEL), D_MODEL ** -0.5),
        'ln2_w': gain(ks[22], (DEPTH, D_MODEL)),
        'w_gate_up': nrm(ks[23], (DEPTH, D_MODEL, 2 * D_FF), D_MODEL ** -0.5),
        'w_down': nrm(ks[24], (DEPTH, D_FF, D_MODEL), D_FF ** -0.5),
    }


def reference(x_prompt, x_sample, cache_k, cache_v, state_delta, state_conv,
              ln1_w, w_in, q_norm_w, k_norm_w, lambda_q1, lambda_k1, lambda_q2, lambda_k2,
              subln_w, w_branch_a, conv_w, a_log, dt_bias, delta_norm_w, w_branch_b,
              w_out, ln2_w, w_gate_up, w_down):
    xp, xs = x_prompt, x_sample
    pk, pv, pd, pc = [], [], [], []
    sk, sv, sd, sc = [], [], [], []
    for l in range(DEPTH):
        lam_init = 0.8 - 0.6 * math.exp(-0.3 * l)
        weights = (ln1_w[l], w_in[l], q_norm_w[l], k_norm_w[l], lambda_q1[l], lambda_k1[l],
                   lambda_q2[l], lambda_k2[l], subln_w[l], w_branch_a[l], conv_w[l], a_log[l],
                   dt_bias[l], delta_norm_w[l], w_branch_b[l], w_out[l], ln2_w[l],
                   w_gate_up[l], w_down[l])
        bp = xp.shape[0]
        zero_conv = jnp.zeros((bp, CONV_W - 1, CONV_CH), xp.dtype)
        zero_s = jnp.zeros((bp, B_HEADS, B_DK, B_DV), jnp.float32)
        xp, k_p, v_p, d_p, c_p = hybrid_layer(xp, None, None, zero_s, zero_conv, lam_init, *weights)
        xs, k_s, v_s, d_s, c_s = hybrid_layer(xs, cache_k[l], cache_v[l], state_delta[l],
                                              state_conv[l], lam_init, *weights)
        pk.append(k_p); pv.append(v_p); pd.append(d_p); pc.append(c_p)
        sk.append(k_s); sv.append(v_s); sd.append(d_s); sc.append(c_s)
    return (xp, xs, jnp.stack(pk), jnp.stack(pv), jnp.stack(pd), jnp.stack(pc),
            jnp.stack(sk), jnp.stack(sv), jnp.stack(sd), jnp.stack(sc))
```

```cpp
#include <hip/hip_runtime.h>
#include <hip/hip_cooperative_groups.h>
#include <cstdio>
#include <cstdint>
namespace cg = cooperative_groups;

#define LAS __attribute__((address_space(3)))
#define GAS __attribute__((address_space(1)))
typedef float f32x2 __attribute__((ext_vector_type(2)));
typedef float f32x16 __attribute__((ext_vector_type(16)));
typedef unsigned u32x2 __attribute__((ext_vector_type(2)));
typedef short s16x4 __attribute__((ext_vector_type(4)));
typedef __bf16 bf16x2_t __attribute__((ext_vector_type(2)));

constexpr int DM = 1024, NB = 16, SEQ = 2048, DECB = 16, DSEQ = 32, PAST = 4096;
constexpr int MP = NB * SEQ, MS = DECB * DSEQ, MT = MP + MS;
constexpr int NH = 8, DIN = 9232, NZ = 9216, DFF = 2816, CONVCH = 3072;
constexpr float EPS = 1e-6f;
constexpr float LAM_INIT = 0.2f;
constexpr float QSCALE = 0.125f * 1.4426950408889634f;
constexpr size_t OFF_Y = 0;
constexpr size_t OFF_KP = (size_t)MT * DM;
constexpr size_t OFF_VP = OFF_KP + (size_t)MP * DM;
constexpr size_t OFF_DP = OFF_VP + (size_t)MP * DM;
constexpr size_t OFF_CP = OFF_DP + (size_t)NB * NH * 128 * 128;
constexpr size_t OFF_KS = OFF_CP + (size_t)NB * 3 * CONVCH;
constexpr size_t OFF_VS = OFF_KS + (size_t)MS * DM;
constexpr size_t OFF_DS = OFF_VS + (size_t)MS * DM;
constexpr size_t OFF_CS = OFF_DS + (size_t)DECB * NH * 128 * 128;
constexpr size_t OUT_TOTAL = OFF_CS + (size_t)DECB * 3 * CONVCH;
static_assert(OUT_TOTAL == 106725376ull, "output size");
#define MEGA 1
namespace pg8 {
#define PG8_LAS __attribute__((address_space(3)))
typedef unsigned short bf16_t;
typedef short bf16x8 __attribute__((ext_vector_type(8)));
typedef float f32x4 __attribute__((ext_vector_type(4)));
typedef unsigned u32x4 __attribute__((ext_vector_type(4)));
constexpr int BM = 256, BK = 64, HALF = 128, HTB = HALF * BK * 2  , STAGE_BYTES = 8 * HTB, NXCD = 8, WGM = 8;

__host__ __device__ __forceinline__ int lds_byte(int r, int c) { const int st = (r >> 4) * 2 + (c >> 5), rr = r & 15, cc = c & 31, ob = rr * 64 + cc * 2; return st * 1024 + (ob ^ (((ob >> 9) & 1) << 5)); }
__host__ __device__ __forceinline__ void stage_rc(int b, int& R, int& C) { const int st = b / 1024, sb = b % 1024, swz = sb ^ (((sb >> 9) & 1) << 5); R = (st >> 1) * 16 + swz / 64; C = (st & 1) * 32 + (swz % 64) / 2; }
__host__ __device__ __forceinline__ int perm32(int rho) { const int n = rho >> 4, i = rho & 15; return 8 * (i >> 2) + 4 * n + (i & 3); }

struct Unit { int pm, pn; };
struct Gemm { const bf16_t* A; const bf16_t* Bt; int M, N, K; };

struct StaticOrder {
    int nM, nN, nwg, G, c;
    __host__ __device__ void init(int M, int N, int G_, int c_) { nM = M / BM; nN = N / BM; nwg = nM * nN; G = G_; c = c_; }
    __host__ __device__ bool next(int i, Unit& u) const {
        const long L = (long)i * G + c; if (L >= nwg) return false;
        int wgid = (int)L; { const int q = nwg / NXCD, r = nwg % NXCD, xcd = wgid % NXCD, off = wgid / NXCD; wgid = (xcd < r ? xcd * (q + 1) : r * (q + 1) + (xcd - r) * q) + off; }
        const int nig = WGM * nN, gid = wgid / nig, fm = gid * WGM, gsz = (nM - fm) < WGM ? (nM - fm) : WGM;
        u.pm = fm + ((wgid % nig) % gsz); u.pn = (wgid % nig) / gsz; return true;
    }
    __device__ __forceinline__ void a_ready(const Unit&) const {}
    __device__ __forceinline__ void done(const Unit&) const {}
};

template <class Epi, class Sched, bool ALIGN_EPI = false, bool SP2 = false>
__device__ __forceinline__ void gemm_phase(PG8_LAS unsigned char* lds, const Gemm g, const Sched& S, const Epi& E) {
    const int tid = threadIdx.x, wid = __builtin_amdgcn_readfirstlane(tid >> 6), lane = tid & 63, wr = wid >> 2, wc = wid & 3, fr = lane & 15, fq = lane >> 4;
    const int K = g.K, nt = K / BK;
    unsigned voffA[2], voffB[2];
#pragma unroll
    for (int i = 0; i < 2; ++i) { int R, C; stage_rc(tid * 16 + i * 8192, R, C); const int Rb = Epi::PERM ? ((R & ~31) + perm32(R & 31)) : R;
        voffA[i] = (unsigned)(R * K + C) * 2u; voffB[i] = (unsigned)(Rb * K + C) * 2u; }
    const size_t kstep = (size_t)(BK * 2);
    const size_t hstep = (size_t)HALF * K * 2;
    const size_t tstep = 2 * hstep;
    const unsigned ldsw = (unsigned)wid * 1024u;
    const int aoff = lds_byte(wr * 64 + fr, fq * 8), boff = lds_byte(wc * 32 + fr, fq * 8);
#define PG8_SA(b, h) (((b) * 2 + (h)) * HTB)
#define PG8_SB(b, h) ((4 + (b) * 2 + (h)) * HTB)
#define PG8_STAGE(bufoff, gbase, voff) do { _Pragma("unroll") for (int _i = 0; _i < 2; ++_i) \
        __builtin_amdgcn_global_load_lds((const unsigned*)((const char*)(gbase) + (voff)[_i]), (PG8_LAS unsigned*)(lds + (bufoff) + ldsw + _i * 8192), 16, 0, 0); } while (0)
#define PG8_LDA(dst, b, h) do { _Pragma("unroll") for (int m = 0; m < 4; ++m) _Pragma("unroll") for (int k = 0; k < 2; ++k) dst[m][k] = *(const PG8_LAS bf16x8*)(lds + PG8_SA(b, h) + aoff + m * 2048 + k * 1024); } while (0)
#define PG8_LDB(dst, b, h) do { _Pragma("unroll") for (int n = 0; n < 2; ++n) _Pragma("unroll") for (int k = 0; k < 2; ++k) dst[n][k] = *(const PG8_LAS bf16x8*)(lds + PG8_SB(b, h) + boff + n * 2048 + k * 1024); } while (0)
#define PG8_MMA(ai, bj, At, Bt) do { __builtin_amdgcn_s_setprio(1); _Pragma("unroll") for (int m = 0; m < 4; ++m) _Pragma("unroll") for (int n = 0; n < 2; ++n) _Pragma("unroll") for (int k = 0; k < 2; ++k) \
        acc[ai][bj][m][n] = __builtin_amdgcn_mfma_f32_16x16x32_bf16(Bt[n][k], At[m][k], acc[ai][bj][m][n], 0, 0, 0); __builtin_amdgcn_s_setprio(0); } while (0)
#define PG8_WAIT_V(n) asm volatile("s_waitcnt vmcnt(" #n ")" ::: "memory")
#define PG8_WAIT_L(n) asm volatile("s_waitcnt lgkmcnt(" #n ")" ::: "memory")
#define PG8_BAR __builtin_amdgcn_s_barrier()
#define PG8_SCHED __builtin_amdgcn_sched_barrier(0)
    Unit cur, nxt; int ui = 0;
    if (!S.next(0, cur)) return;
    f32x4 acc[2][2][4][2];
#pragma unroll
    for (int a = 0; a < 2; ++a)
#pragma unroll
        for (int b = 0; b < 2; ++b)
#pragma unroll
            for (int m = 0; m < 4; ++m)
#pragma unroll
                for (int n = 0; n < 2; ++n) acc[a][b][m][n] = (f32x4){0.f, 0.f, 0.f, 0.f};
    bf16x8 At[4][2], B0[2][2], B1[2][2];
    const char* cA = (const char*)g.A + (size_t)cur.pm * tstep; const char* cB = (const char*)g.Bt + (size_t)cur.pn * tstep;
    S.a_ready(cur);
    if constexpr (SP2) {
        PG8_STAGE(PG8_SB(0, 0), cB, voffB); PG8_STAGE(PG8_SB(0, 1), cB + hstep, voffB); PG8_STAGE(PG8_SA(0, 0), cA, voffA); PG8_STAGE(PG8_SA(0, 1), cA + hstep, voffA);
        if (wr == 1) PG8_BAR;
        PG8_WAIT_V(2); PG8_BAR;
        PG8_STAGE(PG8_SB(1, 0), cB + kstep, voffB); PG8_STAGE(PG8_SA(1, 0), cA + kstep, voffA); PG8_STAGE(PG8_SB(1, 1), cB + hstep + kstep, voffB);
        PG8_WAIT_V(6); PG8_BAR;
    } else {
        PG8_STAGE(PG8_SB(0, 0), cB, voffB); PG8_STAGE(PG8_SA(0, 0), cA, voffA); PG8_STAGE(PG8_SB(0, 1), cB + hstep, voffB); PG8_STAGE(PG8_SA(0, 1), cA + hstep, voffA);
        if (wr == 1) PG8_BAR;
        PG8_WAIT_V(4); PG8_BAR;
        PG8_STAGE(PG8_SB(1, 0), cB + kstep, voffB); PG8_STAGE(PG8_SA(1, 0), cA + kstep, voffA); PG8_STAGE(PG8_SB(1, 1), cB + hstep + kstep, voffB);
        PG8_WAIT_V(6); PG8_BAR;
    }
    for (;;) {
        const bool has_next = S.next(ui + 1, nxt);
        const char* nA = has_next ? (const char*)g.A + (size_t)nxt.pm * tstep : cA; const char* nB = has_next ? (const char*)g.Bt + (size_t)nxt.pn * tstep : cB;
        for (int t = 0; t < nt; t += 2) {
            const bool last = (t == nt - 2);
            const char* a1 = cA + (size_t)(t + 1) * kstep;
            const char* a2 = last ? nA : cA + (size_t)(t + 2) * kstep; const char* b2 = last ? nB : cB + (size_t)(t + 2) * kstep;
            const char* a3 = a2 + kstep; const char* b3 = b2 + kstep;
            if (last && has_next) S.a_ready(nxt);
            if constexpr (SP2) {
            PG8_LDB(B0, 0, 0); PG8_LDB(B1, 0, 1); PG8_SCHED; PG8_LDA(At, 0, 0); PG8_STAGE(PG8_SA(1, 1), a1 + hstep, voffA);
            PG8_WAIT_V(8); PG8_WAIT_L(0); PG8_BAR; PG8_MMA(0, 0, At, B0); PG8_MMA(0, 1, At, B1); PG8_BAR; PG8_SCHED;
            PG8_LDA(At, 0, 1); PG8_STAGE(PG8_SB(0, 0), b2, voffB); PG8_STAGE(PG8_SB(0, 1), b2 + hstep, voffB); PG8_STAGE(PG8_SA(0, 0), a2, voffA);
            PG8_WAIT_V(8); PG8_WAIT_L(0); PG8_BAR; PG8_MMA(1, 0, At, B0); PG8_MMA(1, 1, At, B1); PG8_BAR; PG8_SCHED;
            PG8_LDB(B0, 1, 0); PG8_LDB(B1, 1, 1); PG8_SCHED; PG8_LDA(At, 1, 0); PG8_STAGE(PG8_SA(0, 1), a2 + hstep, voffA);
            PG8_WAIT_V(8); PG8_WAIT_L(0); PG8_BAR; PG8_MMA(0, 0, At, B0); PG8_MMA(0, 1, At, B1); PG8_BAR; PG8_SCHED;
            PG8_LDA(At, 1, 1); PG8_STAGE(PG8_SB(1, 0), b3, voffB); PG8_STAGE(PG8_SB(1, 1), b3 + hstep, voffB); PG8_STAGE(PG8_SA(1, 0), a3, voffA);
            PG8_WAIT_V(8); PG8_WAIT_L(0); PG8_BAR; PG8_MMA(1, 0, At, B0); PG8_MMA(1, 1, At, B1); PG8_BAR; PG8_SCHED;
            } else {
            PG8_LDB(B0, 0, 0); PG8_SCHED; PG8_LDA(At, 0, 0); PG8_STAGE(PG8_SA(1, 1), a1 + hstep, voffA);
            PG8_WAIT_L(8); PG8_BAR; PG8_WAIT_L(0); PG8_MMA(0, 0, At, B0); PG8_BAR; PG8_SCHED;
            PG8_LDB(B1, 0, 1); PG8_STAGE(PG8_SB(0, 0), b2, voffB);
            PG8_BAR; PG8_WAIT_L(0); PG8_MMA(0, 1, At, B1); PG8_BAR;
            PG8_LDA(At, 0, 1); PG8_STAGE(PG8_SA(0, 0), a2, voffA);
            PG8_BAR; PG8_WAIT_L(0); PG8_MMA(1, 0, At, B0); PG8_BAR; PG8_SCHED;
            PG8_STAGE(PG8_SB(0, 1), b2 + hstep, voffB);
            PG8_WAIT_V(6); PG8_BAR; PG8_MMA(1, 1, At, B1); PG8_BAR;
            PG8_LDB(B0, 1, 0); PG8_SCHED; PG8_LDA(At, 1, 0); PG8_STAGE(PG8_SA(0, 1), a2 + hstep, voffA);
            PG8_WAIT_L(8); PG8_BAR; PG8_WAIT_L(0); PG8_MMA(0, 0, At, B0); PG8_BAR; PG8_SCHED;
            PG8_LDB(B1, 1, 1); PG8_STAGE(PG8_SB(1, 0), b3, voffB);
            PG8_BAR; PG8_WAIT_L(0); PG8_MMA(0, 1, At, B1); PG8_BAR;
            PG8_LDA(At, 1, 1); PG8_STAGE(PG8_SA(1, 0), a3, voffA);
            PG8_BAR; PG8_WAIT_L(0); PG8_MMA(1, 0, At, B0); PG8_BAR; PG8_SCHED;
            PG8_STAGE(PG8_SB(1, 1), b3 + hstep, voffB);
            PG8_WAIT_V(6); PG8_BAR; PG8_MMA(1, 1, At, B1); PG8_BAR;
            }
        }
        if constexpr (ALIGN_EPI) { if (wr == 0) PG8_BAR; }
        if constexpr (!Epi::AFTER_DRAIN) { E(acc, cur, wr, wc, fr, fq); S.done(cur); }
        if (!has_next) break;
#pragma unroll
        for (int a = 0; a < 2; ++a)
#pragma unroll
            for (int b = 0; b < 2; ++b)
#pragma unroll
                for (int m = 0; m < 4; ++m)
#pragma unroll
                    for (int n = 0; n < 2; ++n) acc[a][b][m][n] = (f32x4){0.f, 0.f, 0.f, 0.f};
        cur = nxt; cA = nA; cB = nB; ++ui;
        if constexpr (ALIGN_EPI) { if (wr == 1) PG8_BAR; }
    }
    PG8_WAIT_V(0);
    if constexpr (!ALIGN_EPI) { if (wr == 0) PG8_BAR; }
    PG8_BAR;
    if constexpr (Epi::AFTER_DRAIN) { E.fused(acc, cur, wr, wc, fr, fq, lds, wid, lane); S.done(cur); }
#undef PG8_SA
#undef PG8_SB
#undef PG8_STAGE
#undef PG8_LDA
#undef PG8_LDB
#undef PG8_MMA
#undef PG8_WAIT_V
#undef PG8_WAIT_L
#undef PG8_BAR
#undef PG8_SCHED
}
}
using pg8::bf16x8; using pg8::f32x4; using pg8::u32x4;

constexpr size_t MiB = 1u << 20;
constexpr size_t WS_CTL = 0, CTL_ZERO_BYTES = 64 * 1024;
constexpr size_t WS_WIN = 1 * MiB;
constexpr size_t WS_WAB = 19 * MiB;
constexpr size_t WS_WO = 23 * MiB;
constexpr size_t WS_WGU = 25 * MiB;
constexpr size_t WS_WD = 36 * MiB;
constexpr size_t WS_XN = 48 * MiB;
constexpr size_t WS_MERGED = WS_XN;
constexpr size_t WS_RSTD1 = 113 * MiB;
constexpr size_t WS_BETA = 114 * MiB;
constexpr size_t WS_G = 116 * MiB;
constexpr size_t WS_RSS = 118 * MiB;
constexpr size_t WS_PARTO = 121 * MiB;
constexpr size_t WS_PARTL = 129 * MiB;
constexpr size_t WS_QKW = 129 * MiB + 512 * 1024;
constexpr size_t WS_QB = 130 * MiB;
constexpr size_t WS_KB = 195 * MiB;
constexpr size_t WS_VB = 260 * MiB;
constexpr size_t WS_X1B = WS_QB;
constexpr size_t WS_DQKV = 325 * MiB;
constexpr size_t WS_OAB = WS_DQKV;
constexpr size_t WS_QKVC = 520 * MiB;
constexpr size_t WS_ACT = WS_QKVC;
constexpr size_t WS_DG = 715 * MiB;
constexpr size_t WS_GA = 780 * MiB;
constexpr size_t WS_GB = 845 * MiB;
constexpr size_t WS_END = 910 * MiB;
constexpr int CW_Q2 = 64, CW_Q3 = 128;

constexpr int LDS_BYTES = 147456;
constexpr int NWAVES = 8, NTHREADS = 512;

typedef unsigned short bf16;
__device__ __forceinline__ unsigned pk2(float lo, float hi) { f32x2 v = {lo, hi}; bf16x2_t b = __builtin_convertvector(v, bf16x2_t); return __builtin_bit_cast(unsigned, b); }
__device__ __forceinline__ float bflo(unsigned w) { return __uint_as_float(w << 16); }
__device__ __forceinline__ float bfhi(unsigned w) { return __uint_as_float(w & 0xffff0000u); }
__device__ __forceinline__ float bf1(unsigned short h) { return __uint_as_float((unsigned)h << 16); }
__device__ __forceinline__ float wave_sum(float v) {
#pragma unroll
    for (int o = 1; o < 64; o <<= 1) v += __shfl_xor(v, o);
    return v;
}
__device__ __forceinline__ float sigmoidf_(float x) { return 1.f / (1.f + __expf(-x)); }
#define LDS_WAIT() asm volatile("s_waitcnt lgkmcnt(0)" ::: "memory")

struct Args {
    const float* in[25]; float* out; unsigned char* ws; int ph_lo, ph_hi;
};

struct Frame {
    LAS unsigned char* lds;
    unsigned char* ws; float* out;
    const float* const* in;
    int tid, lane, wave, G, bid;
};

__device__ __forceinline__ void tr_item(const float* W, int Nsrc, int scol0, int k0, bf16* WT, int K, int drow0, const float* ksc, LAS float* scr, int lane) {
#pragma unroll 8
    for (int i = 0; i < 32; ++i) { const int kk = 2 * i + (lane >> 5); float v = W[(size_t)(k0 + kk) * Nsrc + scol0 + (lane & 31)]; if (ksc) v *= ksc[k0 + kk]; scr[kk * 33 + (lane & 31)] = v; }
    LDS_WAIT(); asm volatile("" ::: "memory");
    const int c = lane & 7;
#pragma unroll
    for (int j = 0; j < 4; ++j) { const int n = (lane >> 3) + 8 * j; const LAS float* s = scr + (8 * c) * 33 + n;
        u32x4 o; o.x = pk2(s[0 * 33], s[1 * 33]); o.y = pk2(s[2 * 33], s[3 * 33]); o.z = pk2(s[4 * 33], s[5 * 33]); o.w = pk2(s[6 * 33], s[7 * 33]);
        *(u32x4*)(WT + (size_t)(drow0 + n) * K + k0 + 8 * c) = o; }
    LDS_WAIT(); asm volatile("" ::: "memory");
}

__device__ __forceinline__ void p0_prologue(const Frame& F) {
    const float* xp = F.in[0]; const float* xs = F.in[1]; const float* ln1 = F.in[6]; const float* w_in = F.in[7];
    const float* w_a = F.in[15]; const float* w_b = F.in[20]; const float* w_o = F.in[21]; const float* ln2 = F.in[22]; const float* w_gu = F.in[23]; const float* w_d = F.in[24];
    const float* a_log = F.in[17]; const float* dt_bias = F.in[18];
    bf16* WinT = (bf16*)(F.ws + WS_WIN); bf16* WabT = (bf16*)(F.ws + WS_WAB); bf16* WoT = (bf16*)(F.ws + WS_WO); bf16* WguT = (bf16*)(F.ws + WS_WGU); bf16* WdT = (bf16*)(F.ws + WS_WD);
    bf16* XN = (bf16*)(F.ws + WS_XN); float* RSTD1 = (float*)(F.ws + WS_RSTD1); float* BETA = (float*)(F.ws + WS_BETA); float* GARR = (float*)(F.ws + WS_G);
    LAS bf16* W16h = (LAS bf16*)(F.lds); LAS bf16* W16l = (LAS bf16*)(F.lds + 32768);
    LAS float* scr = (LAS float*)(F.lds + 65536 + F.wave * 8448);
    for (int idx = F.tid; idx < 16384; idx += NTHREADS) { const int k = idx >> 4, c = idx & 15; const float v = w_in[(size_t)k * DIN + 7168 + c] * ln1[k];
        const unsigned hi = pk2(v, 0.f) & 0xffffu; const float r = v - bf1((unsigned short)hi); const unsigned lo = pk2(r, 0.f) & 0xffffu;
        const int off = ((((k >> 5) * 4 + ((k >> 3) & 3)) * 16 + c) << 3) + (k & 7); W16h[off] = (bf16)hi; W16l[off] = (bf16)lo; }
    if (F.bid == 0 && F.tid < 128) ((float*)(F.ws + WS_QKW))[F.tid] = F.tid < 64 ? F.in[8][F.tid] : F.in[9][F.tid - 64];
    const int gw = F.bid * NWAVES + F.wave, NGW = F.G * NWAVES;
    constexpr int I_IN = 16 * (NZ / 32), I_AB = 16 * 64, I_O = 16 * 32, I_GU = 16 * (2 * DFF / 32), I_D = (DFF / 64) * 32;
    constexpr int NITEMS = I_IN + I_AB + I_O + I_GU + I_D;
    for (int it = gw; it < NITEMS; it += NGW) {
        int r = it;
        if (r < I_IN) { const int kb = r / (NZ / 32), nb = r % (NZ / 32); const int n = nb * 32, pn = n >> 8, T = n & 255, bj = T >> 7, g = (T & 127) >> 5; const int zc = 256 * pn + 64 * g + 32 * bj;
            tr_item(w_in, DIN, zc < 7168 ? zc : zc + 16, kb * 64, WinT, DM, n, ln1, scr, F.lane); continue; } r -= I_IN;
        if (r < I_AB) { const int kb = r / 64, nb = r % 64; const int n = nb * 32; tr_item(n < 1024 ? w_a : w_b, DM, n & 1023, kb * 64, WabT, DM, n, nullptr, scr, F.lane); continue; } r -= I_AB;
        if (r < I_O) { const int kb = r / 32, nb = r % 32; tr_item(w_o, DM, nb * 32, kb * 64, WoT, DM, nb * 32, nullptr, scr, F.lane); continue; } r -= I_O;
        if (r < I_GU) { const int kb = r / (2 * DFF / 32), nb = r % (2 * DFF / 32); const int n = nb * 32, pn = n >> 8, T = n & 255, bj = T >> 7, cc = T & 127;
            tr_item(w_gu, 2 * DFF, bj * DFF + 128 * pn + cc, kb * 64, WguT, DM, n, ln2, scr, F.lane); continue; } r -= I_GU;
        { const int kb = r / 32, nb = r % 32; tr_item(w_d, DM, nb * 32, kb * 64, WdT, DFF, nb * 32, nullptr, scr, F.lane); }
    }
    __syncthreads();
    const int fr = F.lane & 15, fq = F.lane >> 4;
    for (int grp = gw; grp < MT / 16; grp += NGW) {
        const int row = grp * 16 + fr;
        const float* xr = (row < MP ? xp + (size_t)row * DM : xs + (size_t)(row - MP) * DM) + 8 * fq;
        bf16* xo = XN + (size_t)row * DM + 8 * fq;
        f32x4 acc = {0.f, 0.f, 0.f, 0.f}; float ss = 0.f;
#pragma unroll 4
        for (int s = 0; s < 32; ++s) {
            const f32x4 a = *(const f32x4*)(xr + 32 * s), b = *(const f32x4*)(xr + 32 * s + 4);
            ss += (a.x * a.x + a.y * a.y) + (a.z * a.z + a.w * a.w) + (b.x * b.x + b.y * b.y) + (b.z * b.z + b.w * b.w);
            u32x4 hw; hw.x = pk2(a.x, a.y); hw.y = pk2(a.z, a.w); hw.z = pk2(b.x, b.y); hw.w = pk2(b.z, b.w);
            *(u32x4*)(xo + 32 * s) = hw;
            u32x4 lw; lw.x = pk2(a.x - bflo(hw.x), a.y - bfhi(hw.x)); lw.y = pk2(a.z - bflo(hw.y), a.w - bfhi(hw.y)); lw.z = pk2(b.x - bflo(hw.z), b.y - bfhi(hw.z)); lw.w = pk2(b.z - bflo(hw.w), b.w - bfhi(hw.w));
            const bf16x8 wh = *(const LAS bf16x8*)(W16h + (((s * 4 + fq) * 16 + fr) << 3)), wl = *(const LAS bf16x8*)(W16l + (((s * 4 + fq) * 16 + fr) << 3));
            const bf16x8 xh = __builtin_bit_cast(bf16x8, hw), xl = __builtin_bit_cast(bf16x8, lw);
            acc = __builtin_amdgcn_mfma_f32_16x16x32_bf16(wh, xh, acc, 0, 0, 0);
            acc = __builtin_amdgcn_mfma_f32_16x16x32_bf16(wh, xl, acc, 0, 0, 0);
            acc = __builtin_amdgcn_mfma_f32_16x16x32_bf16(wl, xh, acc, 0, 0, 0);
        }
        ss += __shfl_xor(ss, 16); ss += __shfl_xor(ss, 32);
        const float rstd = rsqrtf(ss * (1.f / DM) + EPS);
        if (fq == 0) RSTD1[row] = rstd;
        if (fq < 2) { f32x4 o; o.x = sigmoidf_(acc.x * rstd); o.y = sigmoidf_(acc.y * rstd); o.z = sigmoidf_(acc.z * rstd); o.w = sigmoidf_(acc.w * rstd); *(f32x4*)(BETA + (size_t)row * 8 + 4 * fq) = o; }
        else { const int h0 = 4 * (fq - 2); f32x4 o;
#pragma unroll
            for (int i = 0; i < 4; ++i) { const float z = acc[i] * rstd + dt_bias[h0 + i]; const float sp = z > 20.f ? z : log1pf(__expf(z)); o[i] = -__expf(a_log[h0 + i]) * sp; }
            *(f32x4*)(GARR + (size_t)row * 8 + h0) = o; }
    }
}

namespace pg8 {
struct PairOrder {
    int G, c;
    __device__ bool next(int i, Unit& u) const { const int P = (i >> 1) * G + c; if (P >= 130 * 4) return false; const int s = i & 1; u.pm = (P >> 2) + 130 * s; u.pn = (P & 3) + 4 * s; return true; }
    __device__ __forceinline__ void a_ready(const Unit&) const {}
    __device__ __forceinline__ void done(const Unit&) const {}
};

struct EpiZ {
    static constexpr bool PERM = true, AFTER_DRAIN = false;
    unsigned char* ws; float* out;
    __device__ __forceinline__ void operator()(const f32x4 (&acc)[2][2][4][2], const Unit& u, int wr, int wc, int fr, int fq) const {
        const int pn = u.pn, row0 = u.pm * BM + wr * 64 + fr;
        const float* rstd = (const float*)(ws + WS_RSTD1);
        f32x4 wv[2][2];
        if (pn < 8) { const float* w = (const float*)(ws + WS_QKW) + (pn < 4 ? 0 : 64); const float sc = pn < 4 ? QSCALE : 1.f;
#pragma unroll
            for (int bj = 0; bj < 2; ++bj)
#pragma unroll
                for (int n = 0; n < 2; ++n) wv[bj][n] = *(const f32x4*)(w + 32 * bj + 8 * fq + 4 * n) * sc; }
#pragma unroll
        for (int ai = 0; ai < 2; ++ai)
#pragma unroll
            for (int m = 0; m < 4; ++m) {
                const int row = row0 + ai * HALF + m * 16; const float rs = rstd[row];
                f32x4 v[2][2];
#pragma unroll
                for (int bj = 0; bj < 2; ++bj)
#pragma unroll
                    for (int n = 0; n < 2; ++n) v[bj][n] = acc[ai][bj][m][n] * rs;
                const int lc = 64 * wc + 8 * fq;
                if (pn < 8) {
                    float ss = 0.f;
#pragma unroll
                    for (int bj = 0; bj < 2; ++bj)
#pragma unroll
                        for (int n = 0; n < 2; ++n) ss += (v[bj][n].x * v[bj][n].x + v[bj][n].y * v[bj][n].y) + (v[bj][n].z * v[bj][n].z + v[bj][n].w * v[bj][n].w);
                    ss += __shfl_xor(ss, 16); ss += __shfl_xor(ss, 32);
                    const float r = rsqrtf(ss * (1.f / 64.f) + EPS);
                    bf16_t* dst = (bf16_t*)(ws + (pn < 4 ? WS_QB : WS_KB)) + (size_t)row * DM + (pn & 3) * 256 + lc;
                    float* ko = out + (row < MP ? OFF_KP + (size_t)row * DM : OFF_KS + (size_t)(row - MP) * DM) + (pn & 3) * 256 + lc;
#pragma unroll
                    for (int bj = 0; bj < 2; ++bj) { const f32x4 o0 = v[bj][0] * r * wv[bj][0], o1 = v[bj][1] * r * wv[bj][1];
                        u32x4 w; w.x = pk2(o0.x, o0.y); w.y = pk2(o0.z, o0.w); w.z = pk2(o1.x, o1.y); w.w = pk2(o1.z, o1.w);
                        *(u32x4*)(dst + 32 * bj) = w;
                        if (pn >= 4) { *(f32x4*)(ko + 32 * bj) = o0; *(f32x4*)(ko + 32 * bj + 4) = o1; } }
                } else if (pn < 12) {
                    bf16_t* dst = (bf16_t*)(ws + WS_VB) + (size_t)row * DM + (pn - 8) * 256 + lc;
                    float* vo = out + (row < MP ? OFF_VP + (size_t)row * DM : OFF_VS + (size_t)(row - MP) * DM) + (pn - 8) * 256 + lc;
#pragma unroll
                    for (int bj = 0; bj < 2; ++bj) { u32x4 w; w.x = pk2(v[bj][0].x, v[bj][0].y); w.y = pk2(v[bj][0].z, v[bj][0].w); w.z = pk2(v[bj][1].x, v[bj][1].y); w.w = pk2(v[bj][1].z, v[bj][1].w);
                        *(u32x4*)(dst + 32 * bj) = w; *(f32x4*)(vo + 32 * bj) = v[bj][0]; *(f32x4*)(vo + 32 * bj + 4) = v[bj][1]; }
                } else if (pn < 24) {
                    const int col = (pn - 12) * 256 + lc; bf16_t* dst = (bf16_t*)(ws + WS_DQKV) + (size_t)row * CONVCH + col;
                    int cr = -1; float* co = nullptr;
                    if (row < MP) { const int t = row & (SEQ - 1); if (t >= SEQ - 3) { cr = t - (SEQ - 3); co = out + OFF_CP + ((size_t)(row >> 11) * 3 + cr) * CONVCH + col; } }
                    else { const int t = (row - MP) & (DSEQ - 1); if (t >= DSEQ - 3) { cr = t - (DSEQ - 3); co = out + OFF_CS + ((size_t)((row - MP) >> 5) * 3 + cr) * CONVCH + col; } }
#pragma unroll
                    for (int bj = 0; bj < 2; ++bj) { u32x4 w; w.x = pk2(v[bj][0].x, v[bj][0].y); w.y = pk2(v[bj][0].z, v[bj][0].w); w.z = pk2(v[bj][1].x, v[bj][1].y); w.w = pk2(v[bj][1].z, v[bj][1].w);
                        *(u32x4*)(dst + 32 * bj) = w; if (cr >= 0) { *(f32x4*)(co + 32 * bj) = v[bj][0]; *(f32x4*)(co + 32 * bj + 4) = v[bj][1]; } }
                } else {
                    bf16_t* dst = (bf16_t*)(ws + (pn < 28 ? WS_DG : (pn < 32 ? WS_GA : WS_GB))) + (size_t)row * DM + (pn & 3) * 256 + lc;
                    const bool sg = pn >= 28;
#pragma unroll
                    for (int bj = 0; bj < 2; ++bj) { f32x4 a = v[bj][0], b = v[bj][1];
                        if (sg) { a.x = sigmoidf_(a.x); a.y = sigmoidf_(a.y); a.z = sigmoidf_(a.z); a.w = sigmoidf_(a.w); b.x = sigmoidf_(b.x); b.y = sigmoidf_(b.y); b.z = sigmoidf_(b.z); b.w = sigmoidf_(b.w); }
                        u32x4 w; w.x = pk2(a.x, a.y); w.y = pk2(a.z, a.w); w.z = pk2(b.x, b.y); w.w = pk2(b.z, b.w); *(u32x4*)(dst + 32 * bj) = w; }
                }
                asm volatile("" ::: "memory");
            }
    }
};

struct EpiAB {
    static constexpr bool PERM = true, AFTER_DRAIN = false;
    unsigned char* ws; float* tmp;
    __device__ __forceinline__ void operator()(const f32x4 (&acc)[2][2][4][2], const Unit& u, int wr, int wc, int fr, int fq) const {
        const int s = u.pm >= 130 ? 1 : 0; const int pm = u.pm - 130 * s, pn = u.pn - 4 * s;
        const int row0 = pm * BM + wr * 64 + fr, col0 = pn * BM + wc * 32 + 8 * fq;
        const bf16_t* G = (const bf16_t*)(ws + (s ? WS_GB : WS_GA)); bf16_t* MERGED = (bf16_t*)(ws + WS_MERGED);
#pragma unroll
        for (int ai = 0; ai < 2; ++ai)
#pragma unroll
            for (int m = 0; m < 4; ++m) { const size_t off = (size_t)(row0 + ai * HALF + m * 16) * DM + col0;
#pragma unroll
                for (int bj = 0; bj < 2; ++bj) { const u32x4 g = *(const u32x4*)(G + off + bj * HALF);
                    f32x4 a = acc[ai][bj][m][0], b = acc[ai][bj][m][1];
                    a.x *= bflo(g.x); a.y *= bfhi(g.x); a.z *= bflo(g.y); a.w *= bfhi(g.y); b.x *= bflo(g.z); b.y *= bfhi(g.z); b.z *= bflo(g.w); b.w *= bfhi(g.w);
                    float* t = tmp + off + bj * HALF;
                    if (s == 0) { *(f32x4*)t = a; *(f32x4*)(t + 4) = b; }
                    else { a += *(const f32x4*)t; b += *(const f32x4*)(t + 4); u32x4 w; w.x = pk2(a.x, a.y); w.y = pk2(a.z, a.w); w.z = pk2(b.x, b.y); w.w = pk2(b.z, b.w); *(u32x4*)(MERGED + off + bj * HALF) = w; } } }
    }
};

struct EpiOut {
    static constexpr bool PERM = true, AFTER_DRAIN = false;
    const float* xp; const float* xs; float* out; bf16_t* X1B; float* RSS;
    __device__ __forceinline__ void operator()(const f32x4 (&acc)[2][2][4][2], const Unit& u, int wr, int wc, int fr, int fq) const {
        const int row0 = u.pm * BM + wr * 64 + fr, col0 = u.pn * BM + wc * 32 + 8 * fq;
#pragma unroll
        for (int ai = 0; ai < 2; ++ai)
#pragma unroll
            for (int m = 0; m < 4; ++m) { const int row = row0 + ai * HALF + m * 16; const size_t off = (size_t)row * DM + col0;
                const float* xr = (row < MP ? xp + (size_t)row * DM : xs + (size_t)(row - MP) * DM) + col0; float ss = 0.f;
#pragma unroll
                for (int bj = 0; bj < 2; ++bj) { const f32x4 a = acc[ai][bj][m][0] + *(const f32x4*)(xr + bj * HALF), b = acc[ai][bj][m][1] + *(const f32x4*)(xr + bj * HALF + 4);
                    ss += (a.x * a.x + a.y * a.y) + (a.z * a.z + a.w * a.w) + (b.x * b.x + b.y * b.y) + (b.z * b.z + b.w * b.w);
                    *(f32x4*)(out + off + bj * HALF) = a; *(f32x4*)(out + off + bj * HALF + 4) = b;
                    u32x4 w; w.x = pk2(a.x, a.y); w.y = pk2(a.z, a.w); w.z = pk2(b.x, b.y); w.w = pk2(b.z, b.w); *(u32x4*)(X1B + off + bj * HALF) = w; }
                ss += __shfl_xor(ss, 16); ss += __shfl_xor(ss, 32);
                if (fq == 0) RSS[(size_t)row * 16 + u.pn * 4 + wc] = ss; }
    }
};

struct EpiGU {
    static constexpr bool PERM = true, AFTER_DRAIN = false;
    const float* RSS; bf16_t* ACT;
    __device__ __forceinline__ void operator()(const f32x4 (&acc)[2][2][4][2], const Unit& u, int wr, int wc, int fr, int fq) const {
        const int row0 = u.pm * BM + wr * 64 + fr, col0 = u.pn * 128 + wc * 32 + 8 * fq;
#pragma unroll
        for (int ai = 0; ai < 2; ++ai)
#pragma unroll
            for (int m = 0; m < 4; ++m) { const int row = row0 + ai * HALF + m * 16;
                const f32x4* rp = (const f32x4*)(RSS + (size_t)row * 16); const f32x4 r0 = rp[0], r1 = rp[1], r2 = rp[2], r3 = rp[3];
                const float ss = ((r0.x + r0.y) + (r0.z + r0.w)) + ((r1.x + r1.y) + (r1.z + r1.w)) + ((r2.x + r2.y) + (r2.z + r2.w)) + ((r3.x + r3.y) + (r3.z + r3.w));
                const float rs = rsqrtf(ss * (1.f / DM) + EPS);
                f32x4 o[2];
#pragma unroll
                for (int n = 0; n < 2; ++n) { const f32x4 g = acc[ai][0][m][n] * rs, uu = acc[ai][1][m][n] * rs;
                    o[n].x = g.x * sigmoidf_(g.x) * uu.x; o[n].y = g.y * sigmoidf_(g.y) * uu.y; o[n].z = g.z * sigmoidf_(g.z) * uu.z; o[n].w = g.w * sigmoidf_(g.w) * uu.w; }
                u32x4 w; w.x = pk2(o[0].x, o[0].y); w.y = pk2(o[0].z, o[0].w); w.z = pk2(o[1].x, o[1].y); w.w = pk2(o[1].z, o[1].w);
                *(u32x4*)(ACT + (size_t)row * DFF + col0) = w; }
    }
};

struct EpiDown {
    static constexpr bool PERM = true, AFTER_DRAIN = false;
    float* out;
    __device__ __forceinline__ void operator()(const f32x4 (&acc)[2][2][4][2], const Unit& u, int wr, int wc, int fr, int fq) const {
        const int row0 = u.pm * BM + wr * 64 + fr, col0 = u.pn * BM + wc * 32 + 8 * fq;
#pragma unroll
        for (int ai = 0; ai < 2; ++ai)
#pragma unroll
            for (int m = 0; m < 4; ++m) { float* o = out + (size_t)(row0 + ai * HALF + m * 16) * DM + col0;
#pragma unroll
                for (int bj = 0; bj < 2; ++bj) { *(f32x4*)(o + bj * HALF) = *(const f32x4*)(o + bj * HALF) + acc[ai][bj][m][0]; *(f32x4*)(o + bj * HALF + 4) = *(const f32x4*)(o + bj * HALF + 4) + acc[ai][bj][m][1]; } }
    }
};
}

__device__ __forceinline__ float lambda_of(const Frame& F) {
    const float* q1 = F.in[10]; const float* k1 = F.in[11]; const float* q2 = F.in[12]; const float* k2 = F.in[13];
    float a = 0.f, b = 0.f;
    for (int i = 0; i < 64; ++i) { a += q1[i] * k1[i]; b += q2[i] * k2[i]; }
    return __expf(a) - __expf(b) + LAM_INIT;
}

__device__ __forceinline__ void conv_task(const Frame& F, int task) {
    const bf16* DQKV = (const bf16*)(F.ws + WS_DQKV); bf16* QKVC = (bf16*)(F.ws + WS_QKVC);
    const float* conv_w = F.in[16]; const float* sconv = F.in[5];
    int lane_ = F.lane; asm volatile("" : "+v"(lane_)); const int run = task / 6, cgp = task % 6; const int c0 = cgp * 512 + lane_ * 8; const int r0 = run * 32;
    const bool sample = r0 >= MP; const int t0 = sample ? 0 : (r0 & (SEQ - 1));
    float w[4][8];
#pragma unroll
    for (int j = 0; j < 4; ++j) { const f32x4 a = *(const f32x4*)(conv_w + j * CONVCH + c0), b = *(const f32x4*)(conv_w + j * CONVCH + c0 + 4); w[j][0] = a.x; w[j][1] = a.y; w[j][2] = a.z; w[j][3] = a.w; w[j][4] = b.x; w[j][5] = b.y; w[j][6] = b.z; w[j][7] = b.w; }
    float h[3][8];
#pragma unroll
    for (int j = 0; j < 3; ++j) {
        if (t0 > 0) { const u32x4 v = *(const u32x4*)(DQKV + (size_t)(r0 - 3 + j) * CONVCH + c0); h[j][0] = bflo(v.x); h[j][1] = bfhi(v.x); h[j][2] = bflo(v.y); h[j][3] = bfhi(v.y); h[j][4] = bflo(v.z); h[j][5] = bfhi(v.z); h[j][6] = bflo(v.w); h[j][7] = bfhi(v.w); }
        else if (sample) { const float* s = sconv + ((size_t)((r0 - MP) >> 5) * 3 + j) * CONVCH + c0; const f32x4 a = *(const f32x4*)s, b = *(const f32x4*)(s + 4); h[j][0] = a.x; h[j][1] = a.y; h[j][2] = a.z; h[j][3] = a.w; h[j][4] = b.x; h[j][5] = b.y; h[j][6] = b.z; h[j][7] = b.w; }
        else {
#pragma unroll
            for (int e = 0; e < 8; ++e) h[j][e] = 0.f; }
    }
    const float qs = cgp < 2 ? 0.08838834764831845f : 1.f; const bool nrm = cgp < 4;
    for (int t = 0; t < 32; ++t) {
        const u32x4 v = *(const u32x4*)(DQKV + (size_t)(r0 + t) * CONVCH + c0);
        float x[8]; x[0] = bflo(v.x); x[1] = bfhi(v.x); x[2] = bflo(v.y); x[3] = bfhi(v.y); x[4] = bflo(v.z); x[5] = bfhi(v.z); x[6] = bflo(v.w); x[7] = bfhi(v.w);
        float y[8]; float ss = 0.f;
#pragma unroll
        for (int e = 0; e < 8; ++e) { float a = w[0][e] * h[0][e] + w[1][e] * h[1][e] + w[2][e] * h[2][e] + w[3][e] * x[e]; a = a * sigmoidf_(a); y[e] = a; ss += a * a; h[0][e] = h[1][e]; h[1][e] = h[2][e]; h[2][e] = x[e]; }
        if (nrm) { ss += __shfl_xor(ss, 1); ss += __shfl_xor(ss, 2); ss += __shfl_xor(ss, 4); ss += __shfl_xor(ss, 8); const float r = rsqrtf(ss + EPS) * qs;
#pragma unroll
            for (int e = 0; e < 8; ++e) y[e] *= r; }
        u32x4 o; o.x = pk2(y[0], y[1]); o.y = pk2(y[2], y[3]); o.z = pk2(y[4], y[5]); o.w = pk2(y[6], y[7]);
        *(u32x4*)(QKVC + (size_t)(r0 + t) * CONVCH + c0) = o;
    }
}

__device__ __forceinline__ int swz_f(int r) { return ((r & 3) << 2) | ((r >> 2) & 3); }
__device__ __forceinline__ int tile_off(int r, int ch) { return 256 * r + 16 * (ch ^ swz_f(r)); }
__device__ __forceinline__ s16x4 vtr(const LAS unsigned char* p) { typedef short v4i16_t __attribute__((ext_vector_type(4))); return __builtin_bit_cast(s16x4, __builtin_amdgcn_ds_read_tr16_b64_v4i16((LAS v4i16_t*)p)); }
__device__ __forceinline__ float exp2_(float x) { return __builtin_amdgcn_exp2f(x); }

__device__ __forceinline__ f32x16 qk_block(const LAS unsigned char* KT, int kb, int m, const bf16x8 (&qf)[4], int r, int hh) {
    f32x16 s = {0.f, 0.f, 0.f, 0.f, 0.f, 0.f, 0.f, 0.f, 0.f, 0.f, 0.f, 0.f, 0.f, 0.f, 0.f, 0.f};
    const int key = 32 * kb + r; const int fz = swz_f(key);
#pragma unroll
    for (int d0 = 0; d0 < 4; ++d0) { const bf16x8 kf = *(const LAS bf16x8*)(KT + 256 * key + 16 * ((8 * m + 2 * d0 + hh) ^ fz)); s = __builtin_amdgcn_mfma_f32_32x32x16_bf16(kf, qf[d0], s, 0, 0, 0); }
    return s;
}
__device__ __forceinline__ float exp_block(f32x16& s) { float a = 0.f;
#pragma unroll
    for (int i = 0; i < 16; ++i) { s[i] = exp2_(s[i]); a += s[i]; }
    return a; }
__device__ __forceinline__ bf16x8 pfrag(const f32x16& p, int s) { u32x4 w; w.x = pk2(p[8 * s + 0], p[8 * s + 1]); w.y = pk2(p[8 * s + 2], p[8 * s + 3]); w.z = pk2(p[8 * s + 4], p[8 * s + 5]); w.w = pk2(p[8 * s + 6], p[8 * s + 7]); return __builtin_bit_cast(bf16x8, w); }
__device__ __forceinline__ bf16x8 vfrag(const LAS unsigned char* VT, int eb, int kb, int s, int lane) {
    const int hh = lane >> 5, gsel = (lane >> 4) & 1, q = (lane >> 2) & 3, p = lane & 3;
    const int row = 32 * kb + 16 * s + 4 * hh + q; const int ch = 4 * eb + 2 * gsel + (p >> 1);
    const s16x4 lo = vtr(VT + 256 * row + 16 * (ch ^ swz_f(row)) + 8 * (p & 1));
    const s16x4 hi = vtr(VT + 256 * (row + 8) + 16 * (ch ^ swz_f(row + 8)) + 8 * (p & 1));
    return (bf16x8){lo[0], lo[1], lo[2], lo[3], hi[0], hi[1], hi[2], hi[3]};
}

template <int BUF> __device__ __forceinline__ void attn_tile(const LAS unsigned char* L, f32x16 (&O)[4], float& l, const bf16x8 (&qf)[4], int krow, int fzm, const int (&vb)[4][2]) {
    const LAS unsigned char* KT = L + BUF * 32768; const LAS unsigned char* VT = KT + 16384;
    bf16x8 p[2][2];
#pragma unroll
    for (int kb = 0; kb < 2; ++kb) {
        f32x16 s;
#pragma unroll
        for (int i = 0; i < 16; ++i) s[i] = 0.f;
#pragma unroll
        for (int d0 = 0; d0 < 4; ++d0) { const bf16x8 kf = *(const LAS bf16x8*)(KT + krow + 8192 * kb + 16 * ((2 * d0) ^ fzm)); s = __builtin_amdgcn_mfma_f32_32x32x16_bf16(kf, qf[d0], s, 0, 0, 0); }
        l += exp_block(s);
        p[kb][0] = pfrag(s, 0); p[kb][1] = pfrag(s, 1);
    }
#pragma unroll
    for (int eb = 0; eb < 4; ++eb) {
#pragma unroll
        for (int kb = 0; kb < 2; ++kb)
#pragma unroll
            for (int s = 0; s < 2; ++s) {
                const s16x4 lo = vtr(VT + vb[eb][0] + 8192 * kb + 4096 * s), hi = vtr(VT + vb[eb][1] + 8192 * kb + 4096 * s);
                O[eb] = __builtin_amdgcn_mfma_f32_32x32x16_bf16((bf16x8){lo[0], lo[1], lo[2], lo[3], hi[0], hi[1], hi[2], hi[3]}, p[kb][s], O[eb], 0, 0, 0); }
    }
}
__device__ __forceinline__ void attn_prompt_unit(const Frame& F, int b, int h, int qb, float lam) {
    const bf16* Qb = (const bf16*)(F.ws + WS_QB); const bf16* Kb = (const bf16*)(F.ws + WS_KB); const bf16* Vb = (const bf16*)(F.ws + WS_VB); bf16* OA = (bf16*)(F.ws + WS_OAB);
    const float* subw = F.in[14];
    int lane = F.lane; asm volatile("" : "+v"(lane)); const int w = F.wave, r = lane & 31, hh = lane >> 5, g = w & 3, m = w >> 2;
    const size_t rowbase = (size_t)b * SEQ; const int q0 = 128 * qb + 32 * g;
    const int NT = 2 * qb + 2, tmax = 2 * qb + (g >> 1);
    const LAS unsigned char* L = F.lds;
    bf16x8 qf[4];
#pragma unroll
    for (int d0 = 0; d0 < 4; ++d0) qf[d0] = *(const bf16x8*)(Qb + (rowbase + q0 + r) * DM + h * 128 + m * 64 + 16 * d0 + 8 * hh);
    const int fzm = swz_f(r) ^ hh ^ (8 * m); const int krow = 256 * r;
    int vb[4][2];
    { const int gsel = (lane >> 4) & 1, q = (lane >> 2) & 3, p = lane & 3;
#pragma unroll
      for (int eb = 0; eb < 4; ++eb)
#pragma unroll
          for (int hl = 0; hl < 2; ++hl) { const int row = 4 * hh + q + 8 * hl; vb[eb][hl] = 256 * row + 16 * ((4 * eb + 2 * gsel + (p >> 1)) ^ swz_f(row)) + 8 * (p & 1); } }
    f32x16 O[4];
#pragma unroll
    for (int eb = 0; eb < 4; ++eb)
#pragma unroll
        for (int i = 0; i < 16; ++i) O[eb][i] = 0.f;
    float l = 0.f;
    const bf16* kg[2]; const bf16* vg[2];
#pragma unroll
    for (int i = 0; i < 2; ++i) { const int row = 4 * (2 * w + i) + (lane >> 4), ch = (lane & 15) ^ swz_f(row); kg[i] = Kb + (rowbase + row) * DM + h * 128 + ch * 8; vg[i] = Vb + (rowbase + row) * DM + h * 128 + ch * 8; }
#define STAGE_T(t, BUF) do { const size_t o_ = (size_t)(t) * 64 * DM; _Pragma("unroll") for (int i_ = 0; i_ < 2; ++i_) { \
        __builtin_amdgcn_global_load_lds((const unsigned*)(kg[i_] + o_), (LAS unsigned*)(F.lds + (BUF) * 32768 + (2 * w + i_) * 1024), 16, 0, 0); \
        __builtin_amdgcn_global_load_lds((const unsigned*)(vg[i_] + o_), (LAS unsigned*)(F.lds + (BUF) * 32768 + 16384 + (2 * w + i_) * 1024), 16, 0, 0); } } while (0)
    __syncthreads();
    STAGE_T(0, 0);
    __syncthreads();
    for (int t = 0; t < NT; t += 2) {
        STAGE_T(t + 1, 1);
        if (t <= tmax) attn_tile<0>(L, O, l, qf, krow, fzm, vb);
        __syncthreads();
        if (t + 2 < NT) STAGE_T(t + 2, 0);
        if (t + 1 <= tmax) attn_tile<1>(L, O, l, qf, krow, fzm, vb);
        __syncthreads();
    }
#undef STAGE_T
    l += __shfl_xor(l, 32);
    LAS float* X = (LAS float*)(F.lds + 65536 + g * 16384);
    if (m == 1) { const float i1 = lam / l;
#pragma unroll
        for (int eb = 0; eb < 4; ++eb)
#pragma unroll
            for (int i = 0; i < 16; ++i) X[(eb * 16 + i) * 64 + lane] = O[eb][i] * i1; }
    __syncthreads();
    if (m == 0) { const float i0 = 1.f / l; float ss = 0.f;
#pragma unroll
        for (int eb = 0; eb < 4; ++eb)
#pragma unroll
            for (int i = 0; i < 16; ++i) { const float o = O[eb][i] * i0 - X[(eb * 16 + i) * 64 + lane]; O[eb][i] = o; ss += o * o; }
        ss += __shfl_xor(ss, 32);
        const float rs = rsqrtf(ss * (1.f / 128.f) + EPS) * (1.f - LAM_INIT);
        bf16* orow = OA + (rowbase + q0 + r) * DM + h * 128;
#pragma unroll
        for (int eb = 0; eb < 4; ++eb)
#pragma unroll
            for (int g4 = 0; g4 < 4; ++g4) { const int e = 32 * eb + 8 * g4 + 4 * hh; const f32x4 sw = *(const f32x4*)(subw + e);
                u32x2 o; o.x = pk2(O[eb][4 * g4 + 0] * rs * sw.x, O[eb][4 * g4 + 1] * rs * sw.y); o.y = pk2(O[eb][4 * g4 + 2] * rs * sw.z, O[eb][4 * g4 + 3] * rs * sw.w);
                *(u32x2*)(orow + e) = o; } }
}

__device__ __forceinline__ void attn_sample_unit(const Frame& F, int b, int h, int sp) {
    const bf16* Qb = (const bf16*)(F.ws + WS_QB); const bf16* Kb = (const bf16*)(F.ws + WS_KB); const bf16* Vb = (const bf16*)(F.ws + WS_VB);
    const float* ck = F.in[2]; const float* cv = F.in[3];
    float* PARTO = (float*)(F.ws + WS_PARTO); float* PARTL = (float*)(F.ws + WS_PARTL);
    int lane = F.lane; asm volatile("" : "+v"(lane)); const int w = F.wave, r = lane & 31, hh = lane >> 5, m = w >> 2, eb = w & 3;
    bf16x8 qf[4];
#pragma unroll
    for (int d0 = 0; d0 < 4; ++d0) qf[d0] = *(const bf16x8*)(Qb + (size_t)(MP + b * DSEQ + r) * DM + h * 128 + m * 64 + 16 * d0 + 8 * hh);
    f32x16 O;
#pragma unroll
    for (int i = 0; i < 16; ++i) O[i] = 0.f;
    float l = 0.f;
    int tid_ = F.tid; asm volatile("" : "+v"(tid_)); const int pr0 = tid_ >> 4, pc = tid_ & 15;
    const int so0 = tile_off(pr0, pc), so1 = tile_off(pr0 + 32, pc);
    const size_t pos0 = (size_t)sp * 2048;
    const float* kg = ck + (((size_t)b * PAST + pos0 + pr0) * NH + h) * 128 + pc * 8; const float* vg = cv + (((size_t)b * PAST + pos0 + pr0) * NH + h) * 128 + pc * 8;
    constexpr size_t RS = (size_t)NH * 128;
    constexpr int NTC = 32;
    const int NT = NTC + (sp == 1 ? 1 : 0);
    f32x4 sk[4], sv[4];
#define LOADC(t) do { const size_t o_ = (size_t)(t) * 64 * RS; sk[0] = *(const f32x4*)(kg + o_); sk[1] = *(const f32x4*)(kg + o_ + 4); sk[2] = *(const f32x4*)(kg + o_ + 32 * RS); sk[3] = *(const f32x4*)(kg + o_ + 32 * RS + 4); \
        sv[0] = *(const f32x4*)(vg + o_); sv[1] = *(const f32x4*)(vg + o_ + 4); sv[2] = *(const f32x4*)(vg + o_ + 32 * RS); sv[3] = *(const f32x4*)(vg + o_ + 32 * RS + 4); } while (0)
#define PK8(a, b_) ((u32x4){pk2((a).x, (a).y), pk2((a).z, (a).w), pk2((b_).x, (b_).y), pk2((b_).z, (b_).w)})
#define STOREC(buf) do { LAS unsigned char* K_ = F.lds + (buf) * 32768; LAS unsigned char* V_ = K_ + 16384; \
        *(LAS u32x4*)(K_ + so0) = PK8(sk[0], sk[1]); *(LAS u32x4*)(K_ + so1) = PK8(sk[2], sk[3]); *(LAS u32x4*)(V_ + so0) = PK8(sv[0], sv[1]); *(LAS u32x4*)(V_ + so1) = PK8(sv[2], sv[3]); } while (0)
    LOADC(0);
    __syncthreads();
    STOREC(0);
    __syncthreads();
    for (int t = 0; t < NT; ++t) {
        const bool more_c = t + 1 < NTC, more_n = (t + 1 == NTC) && (sp == 1);
        u32x4 nk, nv;
        if (more_c) LOADC(t + 1);
        if (more_n) { nk = *(const u32x4*)(Kb + (size_t)(MP + b * DSEQ + pr0) * DM + h * 128 + pc * 8); nv = *(const u32x4*)(Vb + (size_t)(MP + b * DSEQ + pr0) * DM + h * 128 + pc * 8); }
        const LAS unsigned char* KT = F.lds + (t & 1) * 32768; const LAS unsigned char* VT = KT + 16384;
        const int nkb = t < NTC ? 2 : 1;
        {
            f32x16 s0 = qk_block(KT, 0, m, qf, r, hh);
            l += exp_block(s0);
            O = __builtin_amdgcn_mfma_f32_32x32x16_bf16(vfrag(VT, eb, 0, 0, lane), pfrag(s0, 0), O, 0, 0, 0);
            O = __builtin_amdgcn_mfma_f32_32x32x16_bf16(vfrag(VT, eb, 0, 1, lane), pfrag(s0, 1), O, 0, 0, 0);
            if (nkb == 2) {
                f32x16 s1 = qk_block(KT, 1, m, qf, r, hh);
                l += exp_block(s1);
                O = __builtin_amdgcn_mfma_f32_32x32x16_bf16(vfrag(VT, eb, 1, 0, lane), pfrag(s1, 0), O, 0, 0, 0);
                O = __builtin_amdgcn_mfma_f32_32x32x16_bf16(vfrag(VT, eb, 1, 1, lane), pfrag(s1, 1), O, 0, 0, 0);
            }
        }
        if (more_c) STOREC((t + 1) & 1);
        if (more_n) { LAS unsigned char* K_ = F.lds + ((t + 1) & 1) * 32768; LAS unsigned char* V_ = K_ + 16384; *(LAS u32x4*)(K_ + so0) = nk; *(LAS u32x4*)(V_ + so0) = nv; }
        __syncthreads();
    }
#undef LOADC
#undef PK8
#undef STOREC
    l += __shfl_xor(l, 32);
    const size_t pidx = (((size_t)(b * NH + h) * 2 + sp) * 2 + m);
    float* po = PARTO + pidx * 4096;
#pragma unroll
    for (int i = 0; i < 16; ++i) { const int e = 32 * eb + (i & 3) + 8 * (i >> 2) + 4 * hh; po[e * 32 + r] = O[i]; }
    if (eb == 0 && hh == 0) PARTL[pidx * 32 + r] = l;
}

__device__ __forceinline__ void attn_sample_combine(const Frame& F, int b, int h, float lam) {
    const float* PARTO = (const float*)(F.ws + WS_PARTO); const float* PARTL = (const float*)(F.ws + WS_PARTL); bf16* OA = (bf16*)(F.ws + WS_OAB); const float* subw = F.in[14];
    LAS float* red = (LAS float*)F.lds;
    int tid_ = F.tid; asm volatile("" : "+v"(tid_)); const int q = tid_ & 31, eg = tid_ >> 5, e0 = eg * 8;
    const size_t p00 = ((size_t)(b * NH + h) * 2 + 0) * 2, p10 = ((size_t)(b * NH + h) * 2 + 1) * 2;
    const float l0 = PARTL[(p00 + 0) * 32 + q] + PARTL[(p10 + 0) * 32 + q], l1 = PARTL[(p00 + 1) * 32 + q] + PARTL[(p10 + 1) * 32 + q];
    const float i0 = 1.f / l0, i1 = lam / l1;
    float o[8]; float ss = 0.f;
#pragma unroll
    for (int i = 0; i < 8; ++i) { const int e = e0 + i;
        const float a = PARTO[(p00 + 0) * 4096 + e * 32 + q] + PARTO[(p10 + 0) * 4096 + e * 32 + q], c = PARTO[(p00 + 1) * 4096 + e * 32 + q] + PARTO[(p10 + 1) * 4096 + e * 32 + q];
        o[i] = a * i0 - c * i1; ss += o[i] * o[i]; }
    __syncthreads();
    red[q * 16 + eg] = ss;
    __syncthreads();
    float tot = 0.f;
#pragma unroll
    for (int i = 0; i < 16; ++i) tot += red[q * 16 + i];
    const float rs = rsqrtf(tot * (1.f / 128.f) + EPS) * (1.f - LAM_INIT);
    const f32x4 s0 = *(const f32x4*)(subw + e0), s1 = *(const f32x4*)(subw + e0 + 4);
    u32x4 ov; ov.x = pk2(o[0] * rs * s0.x, o[1] * rs * s0.y); ov.y = pk2(o[2] * rs * s0.z, o[3] * rs * s0.w); ov.z = pk2(o[4] * rs * s1.x, o[5] * rs * s1.y); ov.w = pk2(o[6] * rs * s1.z, o[7] * rs * s1.w);
    *(u32x4*)(OA + (size_t)(MP + b * DSEQ + q) * DM + h * 128 + e0) = ov;
}

__device__ __forceinline__ void delta_seq_unit(const Frame& F, int seq, int h) {
    const bf16* QKVC = (const bf16*)(F.ws + WS_QKVC); const float* BETA = (const float*)(F.ws + WS_BETA); const float* GARR = (const float*)(F.ws + WS_G);
    const bf16* DG = (const bf16*)(F.ws + WS_DG); bf16* OB = (bf16*)(F.ws + WS_OAB) + (size_t)MT * DM; const float* dnw = F.in[19];
    const bool sample = seq >= NB; const int L = sample ? DSEQ : SEQ; const size_t row0 = sample ? (size_t)MP + (size_t)(seq - NB) * DSEQ : (size_t)seq * SEQ;
    float* sout = F.out + (sample ? OFF_DS + ((size_t)(seq - NB) * NH + h) * 16384 : OFF_DP + ((size_t)seq * NH + h) * 16384);
    int tid = F.tid; asm volatile("" : "+v"(tid)); const int e = tid & 127, dq = tid >> 7;
    LAS float* Lq = (LAS float*)F.lds; LAS float* Lk = Lq + 4096; LAS float* Lv = Lk + 4096; LAS float* Lb = Lv + 4096; LAS float* Lg = Lb + 32; LAS float* Lqk = Lg + 32;
    LAS float* Lx = Lqk + 32; LAS float* Lo = Lx + 2048;
    float S[32];
    if (sample) { const float* s0 = F.in[4] + ((size_t)(seq - NB) * NH + h) * 16384;
#pragma unroll
        for (int i = 0; i < 32; ++i) S[i] = s0[(32 * dq + i) * 128 + e]; }
    else {
#pragma unroll
        for (int i = 0; i < 32; ++i) S[i] = 0.f; }
    for (int tb = 0; tb < L; tb += 32) {
        __syncthreads();
        { const int f = tid >> 4, c8 = (tid & 15) * 8; const bf16* src = QKVC + (row0 + tb + f) * CONVCH + h * 128 + c8;
#pragma unroll
          for (int part = 0; part < 3; ++part) { const u32x4 v = *(const u32x4*)(src + part * 1024); LAS float* d = (part == 0 ? Lq : part == 1 ? Lk : Lv) + f * 128 + c8;
              *(LAS f32x4*)d = (f32x4){bflo(v.x), bfhi(v.x), bflo(v.y), bfhi(v.y)}; *(LAS f32x4*)(d + 4) = (f32x4){bflo(v.z), bfhi(v.z), bflo(v.w), bfhi(v.w)}; }
          if (tid < 32) { Lb[tid] = BETA[(row0 + tb + tid) * 8 + h]; Lg[tid] = __expf(GARR[(row0 + tb + tid) * 8 + h]); } }
        __syncthreads();
        { const int f = tid >> 4, c8 = (tid & 15) * 8; float a = 0.f;
#pragma unroll
          for (int i = 0; i < 8; ++i) a += Lq[f * 128 + c8 + i] * Lk[f * 128 + c8 + i];
          a += __shfl_xor(a, 1); a += __shfl_xor(a, 2); a += __shfl_xor(a, 4); a += __shfl_xor(a, 8);
          if ((tid & 15) == 0) Lqk[f] = a; }
        __syncthreads();
        for (int f = 0; f < 32; ++f) {
            float pk = 0.f, pq = 0.f;
            const LAS f32x4* kp = (const LAS f32x4*)(Lk + f * 128 + 32 * dq); const LAS f32x4* qp = (const LAS f32x4*)(Lq + f * 128 + 32 * dq);
            float kr[32];
#pragma unroll
            for (int i4 = 0; i4 < 8; ++i4) { const f32x4 kv = kp[i4], qv = qp[i4];
                kr[4 * i4] = kv.x; kr[4 * i4 + 1] = kv.y; kr[4 * i4 + 2] = kv.z; kr[4 * i4 + 3] = kv.w;
                pk += kv.x * S[4 * i4] + kv.y * S[4 * i4 + 1] + kv.z * S[4 * i4 + 2] + kv.w * S[4 * i4 + 3];
                pq += qv.x * S[4 * i4] + qv.y * S[4 * i4 + 1] + qv.z * S[4 * i4 + 2] + qv.w * S[4 * i4 + 3]; }
            LAS float* X = Lx + (f & 1) * 1024;
            X[dq * 128 + e] = pk; X[512 + dq * 128 + e] = pq;
            __syncthreads();
            const float kS = (X[e] + X[128 + e]) + (X[256 + e] + X[384 + e]); const float qS = (X[512 + e] + X[640 + e]) + (X[768 + e] + X[896 + e]);
            const float eg = Lg[f], be = Lb[f];
            const float dl = be * (Lv[f * 128 + e] - eg * kS);
#pragma unroll
            for (int i = 0; i < 32; ++i) S[i] = eg * S[i] + kr[i] * dl;
            if (dq == 0) Lo[f * 128 + e] = eg * qS + Lqk[f] * dl;
        }
        __syncthreads();
        { const int w = F.wave, lane = F.lane;
#pragma unroll
          for (int ff = 0; ff < 4; ++ff) { const int f = 4 * w + ff; const float a = Lo[f * 128 + 2 * lane], c = Lo[f * 128 + 2 * lane + 1];
              const float ss = wave_sum(a * a + c * c); const float rs = rsqrtf(ss * (1.f / 128.f) + EPS);
              const unsigned gw_ = *(const unsigned*)(DG + (row0 + tb + f) * DM + h * 128 + 2 * lane); const float g0 = bflo(gw_), g1 = bfhi(gw_);
              const float o0 = a * rs * dnw[2 * lane] * (g0 * sigmoidf_(g0)), o1 = c * rs * dnw[2 * lane + 1] * (g1 * sigmoidf_(g1));
              *(unsigned*)(OB + (row0 + tb + f) * DM + h * 128 + 2 * lane) = pk2(o0, o1); } }
    }
#pragma unroll
    for (int i = 0; i < 32; ++i) sout[(32 * dq + i) * 128 + e] = S[i];
}

constexpr int N_PHASES = 8;
__device__ __forceinline__ int next_unit(const Frame& F, unsigned* ctr) {
    volatile LAS int* slot = (volatile LAS int*)(F.lds + LDS_BYTES - 16);
    __syncthreads();
    if (F.tid == 0) *slot = (int)__hip_atomic_fetch_add(ctr, 1u, __ATOMIC_RELAXED, __HIP_MEMORY_SCOPE_AGENT);
    __syncthreads();
    return *slot;
}

template <int PH> __device__ __forceinline__ void run_phase(const Frame& F) {
    unsigned char* ws = F.ws;
    if constexpr (PH == 0) { p0_prologue(F); }
    if constexpr (PH == 1) {
        pg8::Gemm g{(const bf16*)(ws + WS_XN), (const bf16*)(ws + WS_WIN), MT, NZ, DM}; pg8::StaticOrder S; S.init(MT, NZ, F.G, F.bid);
        pg8::EpiZ E{ws, F.out};
        pg8::gemm_phase<pg8::EpiZ, pg8::StaticOrder, true, true>(F.lds, g, S, E);
    }
    if constexpr (PH == 2) {
        unsigned* ctr = (unsigned*)(ws + WS_CTL) + CW_Q2;
        for (;;) { const int u = next_unit(F, ctr); if (u >= 256 + 780) break;
            if (u < 256) attn_sample_unit(F, u >> 4, (u >> 1) & 7, u & 1);
            else conv_task(F, (u - 256) * 8 + F.wave); }
    }
    if constexpr (PH == 3) {
        unsigned* ctr = (unsigned*)(ws + WS_CTL) + CW_Q3;
        const float lam = lambda_of(F);
        for (;;) { const int u = next_unit(F, ctr); if (u >= 128 + 2048 + 128 + 128) break;
            if (u < 128) delta_seq_unit(F, u >> 3, u & 7);
            else if (u < 2176) { const int a = u - 128; attn_prompt_unit(F, a & 15, (a >> 4) & 7, 15 - (a >> 7), lam); }
            else if (u < 2304) { const int a = u - 2176; delta_seq_unit(F, NB + (a >> 3), a & 7); }
            else { const int a = u - 2304; attn_sample_combine(F, a >> 3, a & 7, lam); } }
    }
    if constexpr (PH == 4) {
        pg8::Gemm g{(const bf16*)(ws + WS_OAB), (const bf16*)(ws + WS_WAB), 2 * MT, 2048, DM}; pg8::PairOrder S{F.G, F.bid};
        pg8::EpiAB E{ws, F.out + OFF_Y};
        pg8::gemm_phase<pg8::EpiAB, pg8::PairOrder, true, true>(F.lds, g, S, E);
    }
    if constexpr (PH == 5) {
        pg8::Gemm g{(const bf16*)(ws + WS_MERGED), (const bf16*)(ws + WS_WO), MT, DM, DM}; pg8::StaticOrder S; S.init(MT, DM, F.G, F.bid);
        pg8::EpiOut E{F.in[0], F.in[1], F.out + OFF_Y, (bf16*)(ws + WS_X1B), (float*)(ws + WS_RSS)};
        pg8::gemm_phase<pg8::EpiOut, pg8::StaticOrder, true, true>(F.lds, g, S, E);
    }
    if constexpr (PH == 6) {
        pg8::Gemm g{(const bf16*)(ws + WS_X1B), (const bf16*)(ws + WS_WGU), MT, 2 * DFF, DM}; pg8::StaticOrder S; S.init(MT, 2 * DFF, F.G, F.bid);
        pg8::EpiGU E{(const float*)(ws + WS_RSS), (bf16*)(ws + WS_ACT)};
        pg8::gemm_phase<pg8::EpiGU, pg8::StaticOrder, true, true>(F.lds, g, S, E);
    }
    if constexpr (PH == 7) {
        pg8::Gemm g{(const bf16*)(ws + WS_ACT), (const bf16*)(ws + WS_WD), MT, DM, DFF}; pg8::StaticOrder S; S.init(MT, DM, F.G, F.bid);
        pg8::EpiDown E{F.out + OFF_Y};
        pg8::gemm_phase<pg8::EpiDown, pg8::StaticOrder, true, true>(F.lds, g, S, E);
    }
}

__device__ __forceinline__ Frame make_frame(const Args& a, unsigned char* lds) {
    Frame F; F.lds = (LAS unsigned char*)lds; F.ws = a.ws; F.out = a.out; F.in = a.in;
    F.tid = threadIdx.x; F.lane = F.tid & 63; F.wave = __builtin_amdgcn_readfirstlane(F.tid >> 6); F.G = gridDim.x; F.bid = blockIdx.x;
    return F;
}

#if MEGA
__global__ void __launch_bounds__(NTHREADS, 2) mega_kernel(Args a) {
    extern __shared__ __attribute__((aligned(16))) unsigned char lds[];
    cg::grid_group grid = cg::this_grid();
    const Frame F = make_frame(a, lds);
    run_phase<0>(F); grid.sync();
    run_phase<1>(F); grid.sync();
    run_phase<2>(F); grid.sync();
    run_phase<3>(F); grid.sync();
    run_phase<4>(F); grid.sync();
    run_phase<5>(F); grid.sync();
    run_phase<6>(F); grid.sync();
    run_phase<7>(F);
}
#else
template <int PH> __global__ void __launch_bounds__(NTHREADS, 2) phase_kernel(Args a) {
    extern __shared__ __attribute__((aligned(16))) unsigned char lds[];
    const Frame F = make_frame(a, lds);
    run_phase<PH>(F);
}
#endif

extern "C" void kernel_launch(void* const* d_in, const int* in_sizes, int n_in, void* d_out, int out_size, void* d_ws, size_t ws_size, hipStream_t stream) {
    static int grid = 0;
    if (grid == 0) {
        if (n_in != 25 || out_size != (int)OUT_TOTAL || ws_size < WS_END) { fprintf(stderr, "kernel_launch: unexpected shapes n_in %d out %d ws %zu\n", n_in, out_size, ws_size); grid = -1; return; }
        int dev = 0, cus = 0;
        hipGetDevice(&dev); hipDeviceGetAttribute(&cus, hipDeviceAttributeMultiprocessorCount, dev);
#if MEGA
        hipFuncSetAttribute((const void*)mega_kernel, hipFuncAttributeMaxDynamicSharedMemorySize, LDS_BYTES);
        int per_cu = 0; hipOccupancyMaxActiveBlocksPerMultiprocessor(&per_cu, (const void*)mega_kernel, NTHREADS, LDS_BYTES);
        if (per_cu < 1) { fprintf(stderr, "kernel_launch: occupancy query says %d blocks per CU\n", per_cu); per_cu = 1; }
#else
        hipFuncSetAttribute((const void*)phase_kernel<0>, hipFuncAttributeMaxDynamicSharedMemorySize, LDS_BYTES);
        hipFuncSetAttribute((const void*)phase_kernel<1>, hipFuncAttributeMaxDynamicSharedMemorySize, LDS_BYTES);
        hipFuncSetAttribute((const void*)phase_kernel<2>, hipFuncAttributeMaxDynamicSharedMemorySize, LDS_BYTES);
        hipFuncSetAttribute((const void*)phase_kernel<3>, hipFuncAttributeMaxDynamicSharedMemorySize, LDS_BYTES);
        hipFuncSetAttribute((const void*)phase_kernel<4>, hipFuncAttributeMaxDynamicSharedMemorySize, LDS_BYTES);
        hipFuncSetAttribute((const void*)phase_kernel<5>, hipFuncAttributeMaxDynamicSharedMemorySize, LDS_BYTES);
        hipFuncSetAttribute((const void*)phase_kernel<6>, hipFuncAttributeMaxDynamicSharedMemorySize, LDS_BYTES);
        hipFuncSetAttribute((const void*)phase_kernel<7>, hipFuncAttributeMaxDynamicSharedMemorySize, LDS_BYTES);
#endif
        (void)hipGetLastError();
        grid = cus > 0 ? cus : 256;
    }
    if (grid < 0) return;
    hipMemsetAsync((char*)d_ws + WS_CTL, 0, CTL_ZERO_BYTES, stream);
    Args a{};
    for (int i = 0; i < 25; ++i) a.in[i] = (const float*)d_in[i];
    a.out = (float*)d_out; a.ws = (unsigned char*)d_ws; a.ph_lo = 0; a.ph_hi = N_PHASES;
#if MEGA
    void* args[] = {&a};
    hipError_t e = hipLaunchCooperativeKernel((const void*)mega_kernel, dim3(grid), dim3(NTHREADS), args, LDS_BYTES, stream);
    if (e != hipSuccess) fprintf(stderr, "cooperative launch failed: %s (grid %d)\n", hipGetErrorString(e), grid);
#else
    hipLaunchKernelGGL(phase_kernel<0>, dim3(grid), dim3(NTHREADS), LDS_BYTES, stream, a);
    hipLaunchKernelGGL(phase_kernel<1>, dim3(grid), dim3(NTHREADS), LDS_BYTES, stream, a);
    hipLaunchKernelGGL(phase_kernel<2>, dim3(grid), dim3(NTHREADS), LDS_BYTES, stream, a);
    hipLaunchKernelGGL(phase_kernel<3>, dim3(grid), dim3(NTHREADS), LDS_BYTES, stream, a);
    hipLaunchKernelGGL(phase_kernel<4>, dim3(grid), dim3(NTHREADS), LDS_BYTES, stream, a);
    hipLaunchKernelGGL(phase_kernel<5>, dim3(grid), dim3(NTHREADS), LDS_BYTES, stream, a);
    hipLaunchKernelGGL(phase_kernel<6>, dim3(grid), dim3(NTHREADS), LDS_BYTES, stream, a);
    hipLaunchKernelGGL(phase_kernel<7>, dim3(grid), dim3(NTHREADS), LDS_BYTES, stream, a);
#endif
}
```

```cpp
#include <hip/hip_runtime.h>
#include <hip/hip_cooperative_groups.h>
#include <cstdio>
#include <cstdint>
namespace cg = cooperative_groups;

#define LAS __attribute__((address_space(3)))
#define GAS __attribute__((address_space(1)))
typedef float f32x2 __attribute__((ext_vector_type(2)));
typedef float f32x16 __attribute__((ext_vector_type(16)));
typedef unsigned u32x2 __attribute__((ext_vector_type(2)));
typedef short s16x4 __attribute__((ext_vector_type(4)));
typedef __bf16 bf16x2_t __attribute__((ext_vector_type(2)));

constexpr int DM = 1024, NB = 16, SEQ = 2048, DECB = 16, DSEQ = 32, PAST = 4096;
constexpr int MP = NB * SEQ, MS = DECB * DSEQ, MT = MP + MS;
constexpr int NH = 8, DIN = 9232, NZ = 9216, DFF = 2816, CONVCH = 3072;
constexpr float EPS = 1e-6f;
constexpr float LAM_INIT = 0.2f;
constexpr float QSCALE = 0.125f * 1.4426950408889634f;
constexpr size_t OFF_Y = 0;
constexpr size_t OFF_KP = (size_t)MT * DM;
constexpr size_t OFF_VP = OFF_KP + (size_t)MP * DM;
constexpr size_t OFF_DP = OFF_VP + (size_t)MP * DM;
constexpr size_t OFF_CP = OFF_DP + (size_t)NB * NH * 128 * 128;
constexpr size_t OFF_KS = OFF_CP + (size_t)NB * 3 * CONVCH;
constexpr size_t OFF_VS = OFF_KS + (size_t)MS * DM;
constexpr size_t OFF_DS = OFF_VS + (size_t)MS * DM;
constexpr size_t OFF_CS = OFF_DS + (size_t)DECB * NH * 128 * 128;
constexpr size_t OUT_TOTAL = OFF_CS + (size_t)DECB * 3 * CONVCH;
static_assert(OUT_TOTAL == 106725376ull, "output size");
#define MEGA 1

namespace pg8 {
#define PG8_LAS __attribute__((address_space(3)))
typedef unsigned short bf16_t;
typedef short bf16x8 __attribute__((ext_vector_type(8)));
typedef float f32x4 __attribute__((ext_vector_type(4)));
typedef unsigned u32x4 __attribute__((ext_vector_type(4)));
constexpr int BM = 256, BK = 64, HALF = 128, HTB = HALF * BK * 2  , STAGE_BYTES = 8 * HTB, NXCD = 8, WGM = 8;

__host__ __device__ __forceinline__ int lds_byte(int r, int c) { const int st = (r >> 4) * 2 + (c >> 5), rr = r & 15, cc = c & 31, ob = rr * 64 + cc * 2; return st * 1024 + (ob ^ (((ob >> 9) & 1) << 5)); }
__host__ __device__ __forceinline__ void stage_rc(int b, int& R, int& C) { const int st = b / 1024, sb = b % 1024, swz = sb ^ (((sb >> 9) & 1) << 5); R = (st >> 1) * 16 + swz / 64; C = (st & 1) * 32 + (swz % 64) / 2; }
__host__ __device__ __forceinline__ int perm32(int rho) { const int n = rho >> 4, i = rho & 15; return 8 * (i >> 2) + 4 * n + (i & 3); }

struct Unit { int pm, pn; };
struct Gemm { const bf16_t* A; const bf16_t* Bt; int M, N, K; };

struct StaticOrder {
    int nM, nN, nwg, G, c;
    __host__ __device__ void init(int M, int N, int G_, int c_) { nM = M / BM; nN = N / BM; nwg = nM * nN; G = G_; c = c_; }
    __host__ __device__ bool next(int i, Unit& u) const {
        const long L = (long)i * G + c; if (L >= nwg) return false;
        int wgid = (int)L; { const int q = nwg / NXCD, r = nwg % NXCD, xcd = wgid % NXCD, off = wgid / NXCD; wgid = (xcd < r ? xcd * (q + 1) : r * (q + 1) + (xcd - r) * q) + off; }
        const int nig = WGM * nN, gid = wgid / nig, fm = gid * WGM, gsz = (nM - fm) < WGM ? (nM - fm) : WGM;
        u.pm = fm + ((wgid % nig) % gsz); u.pn = (wgid % nig) / gsz; return true;
    }
    __device__ __forceinline__ void a_ready(const Unit&) const {}
    __device__ __forceinline__ void done(const Unit&) const {}
};

template <class Epi, class Sched, bool ALIGN_EPI = false, bool SP2 = false>
__device__ __forceinline__ void gemm_phase(PG8_LAS unsigned char* lds, const Gemm g, const Sched& S, const Epi& E) {
    const int tid = threadIdx.x, wid = __builtin_amdgcn_readfirstlane(tid >> 6), lane = tid & 63, wr = wid >> 2, wc = wid & 3, fr = lane & 15, fq = lane >> 4;
    const int K = g.K, nt = K / BK;
    unsigned voffA[2], voffB[2];
#pragma unroll
    for (int i = 0; i < 2; ++i) { int R, C; stage_rc(tid * 16 + i * 8192, R, C); const int Rb = Epi::PERM ? ((R & ~31) + perm32(R & 31)) : R;
        voffA[i] = (unsigned)(R * K + C) * 2u; voffB[i] = (unsigned)(Rb * K + C) * 2u; }
    const size_t kstep = (size_t)(BK * 2);
    const size_t hstep = (size_t)HALF * K * 2;
    const size_t tstep = 2 * hstep;
    const unsigned ldsw = (unsigned)wid * 1024u;
    const int aoff = lds_byte(wr * 64 + fr, fq * 8), boff = lds_byte(wc * 32 + fr, fq * 8);
#define PG8_SA(b, h) (((b) * 2 + (h)) * HTB)
#define PG8_SB(b, h) ((4 + (b) * 2 + (h)) * HTB)
#define PG8_STAGE(bufoff, gbase, voff) do { _Pragma("unroll") for (int _i = 0; _i < 2; ++_i) \
        __builtin_amdgcn_global_load_lds((const unsigned*)((const char*)(gbase) + (voff)[_i]), (PG8_LAS unsigned*)(lds + (bufoff) + ldsw + _i * 8192), 16, 0, 0); } while (0)
#define PG8_LDA(dst, b, h) do { _Pragma("unroll") for (int m = 0; m < 4; ++m) _Pragma("unroll") for (int k = 0; k < 2; ++k) dst[m][k] = *(const PG8_LAS bf16x8*)(lds + PG8_SA(b, h) + aoff + m * 2048 + k * 1024); } while (0)
#define PG8_LDB(dst, b, h) do { _Pragma("unroll") for (int n = 0; n < 2; ++n) _Pragma("unroll") for (int k = 0; k < 2; ++k) dst[n][k] = *(const PG8_LAS bf16x8*)(lds + PG8_SB(b, h) + boff + n * 2048 + k * 1024); } while (0)
#define PG8_MMA(ai, bj, At, Bt) do { __builtin_amdgcn_s_setprio(1); _Pragma("unroll") for (int m = 0; m < 4; ++m) _Pragma("unroll") for (int n = 0; n < 2; ++n) _Pragma("unroll") for (int k = 0; k < 2; ++k) \
        acc[ai][bj][m][n] = __builtin_amdgcn_mfma_f32_16x16x32_bf16(Bt[n][k], At[m][k], acc[ai][bj][m][n], 0, 0, 0); __builtin_amdgcn_s_setprio(0); } while (0)
#define PG8_WAIT_V(n) asm volatile("s_waitcnt vmcnt(" #n ")" ::: "memory")
#define PG8_WAIT_L(n) asm volatile("s_waitcnt lgkmcnt(" #n ")" ::: "memory")
#define PG8_BAR __builtin_amdgcn_s_barrier()
#define PG8_SCHED __builtin_amdgcn_sched_barrier(0)
    Unit cur, nxt; int ui = 0;
    if (!S.next(0, cur)) return;
    f32x4 acc[2][2][4][2];
#pragma unroll
    for (int a = 0; a < 2; ++a)
#pragma unroll
        for (int b = 0; b < 2; ++b)
#pragma unroll
            for (int m = 0; m < 4; ++m)
#pragma unroll
                for (int n = 0; n < 2; ++n) acc[a][b][m][n] = (f32x4){0.f, 0.f, 0.f, 0.f};
    bf16x8 At[4][2], B0[2][2], B1[2][2];
    const char* cA = (const char*)g.A + (size_t)cur.pm * tstep; const char* cB = (const char*)g.Bt + (size_t)cur.pn * tstep;
    S.a_ready(cur);
    if constexpr (SP2) {
        PG8_STAGE(PG8_SB(0, 0), cB, voffB); PG8_STAGE(PG8_SB(0, 1), cB + hstep, voffB); PG8_STAGE(PG8_SA(0, 0), cA, voffA); PG8_STAGE(PG8_SA(0, 1), cA + hstep, voffA);
        if (wr == 1) PG8_BAR;
        PG8_WAIT_V(2); PG8_BAR;
        PG8_STAGE(PG8_SB(1, 0), cB + kstep, voffB); PG8_STAGE(PG8_SA(1, 0), cA + kstep, voffA); PG8_STAGE(PG8_SB(1, 1), cB + hstep + kstep, voffB);
        PG8_WAIT_V(6); PG8_BAR;
    } else {
        PG8_STAGE(PG8_SB(0, 0), cB, voffB); PG8_STAGE(PG8_SA(0, 0), cA, voffA); PG8_STAGE(PG8_SB(0, 1), cB + hstep, voffB); PG8_STAGE(PG8_SA(0, 1), cA + hstep, voffA);
        if (wr == 1) PG8_BAR;
        PG8_WAIT_V(4); PG8_BAR;
        PG8_STAGE(PG8_SB(1, 0), cB + kstep, voffB); PG8_STAGE(PG8_SA(1, 0), cA + kstep, voffA); PG8_STAGE(PG8_SB(1, 1), cB + hstep + kstep, voffB);
        PG8_WAIT_V(6); PG8_BAR;
    }
    for (;;) {
        const bool has_next = S.next(ui + 1, nxt);
        const char* nA = has_next ? (const char*)g.A + (size_t)nxt.pm * tstep : cA; const char* nB = has_next ? (const char*)g.Bt + (size_t)nxt.pn * tstep : cB;
        for (int t = 0; t < nt; t += 2) {
            const bool last = (t == nt - 2);
            const char* a1 = cA + (size_t)(t + 1) * kstep;
            const char* a2 = last ? nA : cA + (size_t)(t + 2) * kstep; const char* b2 = last ? nB : cB + (size_t)(t + 2) * kstep;
            const char* a3 = a2 + kstep; const char* b3 = b2 + kstep;
            if (last && has_next) S.a_ready(nxt);
            if constexpr (SP2) {
            PG8_LDB(B0, 0, 0); PG8_LDB(B1, 0, 1); PG8_SCHED; PG8_LDA(At, 0, 0); PG8_STAGE(PG8_SA(1, 1), a1 + hstep, voffA);
            PG8_WAIT_V(8); PG8_WAIT_L(0); PG8_BAR; PG8_MMA(0, 0, At, B0); PG8_MMA(0, 1, At, B1); PG8_BAR; PG8_SCHED;
            PG8_LDA(At, 0, 1); PG8_STAGE(PG8_SB(0, 0), b2, voffB); PG8_STAGE(PG8_SB(0, 1), b2 + hstep, voffB); PG8_STAGE(PG8_SA(0, 0), a2, voffA);
            PG8_WAIT_V(8); PG8_WAIT_L(0); PG8_BAR; PG8_MMA(1, 0, At, B0); PG8_MMA(1, 1, At, B1); PG8_BAR; PG8_SCHED;
            PG8_LDB(B0, 1, 0); PG8_LDB(B1, 1, 1); PG8_SCHED; PG8_LDA(At, 1, 0); PG8_STAGE(PG8_SA(0, 1), a2 + hstep, voffA);
            PG8_WAIT_V(8); PG8_WAIT_L(0); PG8_BAR; PG8_MMA(0, 0, At, B0); PG8_MMA(0, 1, At, B1); PG8_BAR; PG8_SCHED;
            PG8_LDA(At, 1, 1); PG8_STAGE(PG8_SB(1, 0), b3, voffB); PG8_STAGE(PG8_SB(1, 1), b3 + hstep, voffB); PG8_STAGE(PG8_SA(1, 0), a3, voffA);
            PG8_WAIT_V(8); PG8_WAIT_L(0); PG8_BAR; PG8_MMA(1, 0, At, B0); PG8_MMA(1, 1, At, B1); PG8_BAR; PG8_SCHED;
            } else {
            PG8_LDB(B0, 0, 0); PG8_SCHED; PG8_LDA(At, 0, 0); PG8_STAGE(PG8_SA(1, 1), a1 + hstep, voffA);
            PG8_WAIT_L(8); PG8_BAR; PG8_WAIT_L(0); PG8_MMA(0, 0, At, B0); PG8_BAR; PG8_SCHED;
            PG8_LDB(B1, 0, 1); PG8_STAGE(PG8_SB(0, 0), b2, voffB);
            PG8_BAR; PG8_WAIT_L(0); PG8_MMA(0, 1, At, B1); PG8_BAR;
            PG8_LDA(At, 0, 1); PG8_STAGE(PG8_SA(0, 0), a2, voffA);
            PG8_BAR; PG8_WAIT_L(0); PG8_MMA(1, 0, At, B0); PG8_BAR; PG8_SCHED;
            PG8_STAGE(PG8_SB(0, 1), b2 + hstep, voffB);
            PG8_WAIT_V(6); PG8_BAR; PG8_MMA(1, 1, At, B1); PG8_BAR;
            PG8_LDB(B0, 1, 0); PG8_SCHED; PG8_LDA(At, 1, 0); PG8_STAGE(PG8_SA(0, 1), a2 + hstep, voffA);
            PG8_WAIT_L(8); PG8_BAR; PG8_WAIT_L(0); PG8_MMA(0, 0, At, B0); PG8_BAR; PG8_SCHED;
            PG8_LDB(B1, 1, 1); PG8_STAGE(PG8_SB(1, 0), b3, voffB);
            PG8_BAR; PG8_WAIT_L(0); PG8_MMA(0, 1, At, B1); PG8_BAR;
            PG8_LDA(At, 1, 1); PG8_STAGE(PG8_SA(1, 0), a3, voffA);
            PG8_BAR; PG8_WAIT_L(0); PG8_MMA(1, 0, At, B0); PG8_BAR; PG8_SCHED;
            PG8_STAGE(PG8_SB(1, 1), b3 + hstep, voffB);
            PG8_WAIT_V(6); PG8_BAR; PG8_MMA(1, 1, At, B1); PG8_BAR;
            }
        }
        if constexpr (ALIGN_EPI) { if (wr == 0) PG8_BAR; }
        if constexpr (!Epi::AFTER_DRAIN) { E(acc, cur, wr, wc, fr, fq); S.done(cur); }
        if (!has_next) break;
#pragma unroll
        for (int a = 0; a < 2; ++a)
#pragma unroll
            for (int b = 0; b < 2; ++b)
#pragma unroll
                for (int m = 0; m < 4; ++m)
#pragma unroll
                    for (int n = 0; n < 2; ++n) acc[a][b][m][n] = (f32x4){0.f, 0.f, 0.f, 0.f};
        cur = nxt; cA = nA; cB = nB; ++ui;
        if constexpr (ALIGN_EPI) { if (wr == 1) PG8_BAR; }
    }
    PG8_WAIT_V(0);
    if constexpr (!ALIGN_EPI) { if (wr == 0) PG8_BAR; }
    PG8_BAR;
    if constexpr (Epi::AFTER_DRAIN) { E.fused(acc, cur, wr, wc, fr, fq, lds, wid, lane); S.done(cur); }
#undef PG8_SA
#undef PG8_SB
#undef PG8_STAGE
#undef PG8_LDA
#undef PG8_LDB
#undef PG8_MMA
#undef PG8_WAIT_V
#undef PG8_WAIT_L
#undef PG8_BAR
#undef PG8_SCHED
}
}
using pg8::bf16x8; using pg8::f32x4; using pg8::u32x4;

constexpr size_t MiB = 1u << 20;
constexpr size_t WS_CTL = 0, CTL_ZERO_BYTES = 64 * 1024;
constexpr size_t WS_WIN = 1 * MiB;
constexpr size_t WS_WAB = 19 * MiB;
constexpr size_t WS_WO = 23 * MiB;
constexpr size_t WS_WGU = 25 * MiB;
constexpr size_t WS_WD = 36 * MiB;
constexpr size_t WS_XN = 48 * MiB;
constexpr size_t WS_MERGED = WS_XN;
constexpr size_t WS_RSTD1 = 113 * MiB;
constexpr size_t WS_BETA = 114 * MiB;
constexpr size_t WS_G = 116 * MiB;
constexpr size_t WS_RSS = 118 * MiB;
constexpr size_t WS_PARTO = 121 * MiB;
constexpr size_t WS_PARTL = 129 * MiB;
constexpr size_t WS_QKW = 129 * MiB + 512 * 1024;
constexpr size_t WS_QB = 130 * MiB;
constexpr size_t WS_KB = 195 * MiB;
constexpr size_t WS_VB = 260 * MiB;
constexpr size_t WS_X1B = WS_QB;
constexpr size_t WS_DQKV = 325 * MiB;
constexpr size_t WS_OAB = WS_DQKV;
constexpr size_t WS_QKVC = 520 * MiB;
constexpr size_t WS_ACT = WS_QKVC;
constexpr size_t WS_DG = 715 * MiB;
constexpr size_t WS_GA = 780 * MiB;
constexpr size_t WS_GB = 845 * MiB;
constexpr size_t WS_END = 910 * MiB;
constexpr int CW_Q2 = 64, CW_Q3 = 128;

constexpr int LDS_BYTES = 147456;
constexpr int NWAVES = 8, NTHREADS = 512;

typedef unsigned short bf16;
__device__ __forceinline__ unsigned pk2(float lo, float hi) { f32x2 v = {lo, hi}; bf16x2_t b = __builtin_convertvector(v, bf16x2_t); return __builtin_bit_cast(unsigned, b); }
__device__ __forceinline__ float bflo(unsigned w) { return __uint_as_float(w << 16); }
__device__ __forceinline__ float bfhi(unsigned w) { return __uint_as_float(w & 0xffff0000u); }
__device__ __forceinline__ float bf1(unsigned short h) { return __uint_as_float((unsigned)h << 16); }
__device__ __forceinline__ float wave_sum(float v) {
#pragma unroll
    for (int o = 1; o < 64; o <<= 1) v += __shfl_xor(v, o);
    return v;
}
__device__ __forceinline__ float sigmoidf_(float x) { return 1.f / (1.f + __expf(-x)); }
#define LDS_WAIT() asm volatile("s_waitcnt lgkmcnt(0)" ::: "memory")

struct Args {
    const float* in[25]; float* out; unsigned char* ws; int ph_lo, ph_hi;
};

struct Frame {
    LAS unsigned char* lds;
    unsigned char* ws; float* out;
    const float* const* in;
    int tid, lane, wave, G, bid;
};

__device__ __forceinline__ void tr_item(const float* W, int Nsrc, int scol0, int k0, bf16* WT, int K, int drow0, const float* ksc, LAS float* scr, int lane) {
#pragma unroll 8
    for (int i = 0; i < 32; ++i) { const int kk = 2 * i + (lane >> 5); float v = W[(size_t)(k0 + kk) * Nsrc + scol0 + (lane & 31)]; if (ksc) v *= ksc[k0 + kk]; scr[kk * 33 + (lane & 31)] = v; }
    LDS_WAIT(); asm volatile("" ::: "memory");
    const int c = lane & 7;
#pragma unroll
    for (int j = 0; j < 4; ++j) { const int n = (lane >> 3) + 8 * j; const LAS float* s = scr + (8 * c) * 33 + n;
        u32x4 o; o.x = pk2(s[0 * 33], s[1 * 33]); o.y = pk2(s[2 * 33], s[3 * 33]); o.z = pk2(s[4 * 33], s[5 * 33]); o.w = pk2(s[6 * 33], s[7 * 33]);
        *(u32x4*)(WT + (size_t)(drow0 + n) * K + k0 + 8 * c) = o; }
    LDS_WAIT(); asm volatile("" ::: "memory");
}

__device__ __forceinline__ void p0_prologue(const Frame& F) {
    const float* xp = F.in[0]; const float* xs = F.in[1]; const float* ln1 = F.in[6]; const float* w_in = F.in[7];
    const float* w_a = F.in[15]; const float* w_b = F.in[20]; const float* w_o = F.in[21]; const float* ln2 = F.in[22]; const float* w_gu = F.in[23]; const float* w_d = F.in[24];
    const float* a_log = F.in[17]; const float* dt_bias = F.in[18];
    bf16* WinT = (bf16*)(F.ws + WS_WIN); bf16* WabT = (bf16*)(F.ws + WS_WAB); bf16* WoT = (bf16*)(F.ws + WS_WO); bf16* WguT = (bf16*)(F.ws + WS_WGU); bf16* WdT = (bf16*)(F.ws + WS_WD);
    bf16* XN = (bf16*)(F.ws + WS_XN); float* RSTD1 = (float*)(F.ws + WS_RSTD1); float* BETA = (float*)(F.ws + WS_BETA); float* GARR = (float*)(F.ws + WS_G);
    LAS bf16* W16h = (LAS bf16*)(F.lds); LAS bf16* W16l = (LAS bf16*)(F.lds + 32768);
    LAS float* scr = (LAS float*)(F.lds + 65536 + F.wave * 8448);
    for (int idx = F.tid; idx < 16384; idx += NTHREADS) { const int k = idx >> 4, c = idx & 15; const float v = w_in[(size_t)k * DIN + 7168 + c] * ln1[k];
        const unsigned hi = pk2(v, 0.f) & 0xffffu; const float r = v - bf1((unsigned short)hi); const unsigned lo = pk2(r, 0.f) & 0xffffu;
        const int off = ((((k >> 5) * 4 + ((k >> 3) & 3)) * 16 + c) << 3) + (k & 7); W16h[off] = (bf16)hi; W16l[off] = (bf16)lo; }
    if (F.bid == 0 && F.tid < 128) ((float*)(F.ws + WS_QKW))[F.tid] = F.tid < 64 ? F.in[8][F.tid] : F.in[9][F.tid - 64];
    const int gw = F.bid * NWAVES + F.wave, NGW = F.G * NWAVES;
    constexpr int I_IN = 16 * (NZ / 32), I_AB = 16 * 64, I_O = 16 * 32, I_GU = 16 * (2 * DFF / 32), I_D = (DFF / 64) * 32;
    constexpr int NITEMS = I_IN + I_AB + I_O + I_GU + I_D;
    for (int it = gw; it < NITEMS; it += NGW) {
        int r = it;
        if (r < I_IN) { const int kb = r / (NZ / 32), nb = r % (NZ / 32); const int n = nb * 32, pn = n >> 8, T = n & 255, bj = T >> 7, g = (T & 127) >> 5; const int zc = 256 * pn + 64 * g + 32 * bj;
            tr_item(w_in, DIN, zc < 7168 ? zc : zc + 16, kb * 64, WinT, DM, n, ln1, scr, F.lane); continue; } r -= I_IN;
        if (r < I_AB) { const int kb = r / 64, nb = r % 64; const int n = nb * 32; tr_item(n < 1024 ? w_a : w_b, DM, n & 1023, kb * 64, WabT, DM, n, nullptr, scr, F.lane); continue; } r -= I_AB;
        if (r < I_O) { const int kb = r / 32, nb = r % 32; tr_item(w_o, DM, nb * 32, kb * 64, WoT, DM, nb * 32, nullptr, scr, F.lane); continue; } r -= I_O;
        if (r < I_GU) { const int kb = r / (2 * DFF / 32), nb = r % (2 * DFF / 32); const int n = nb * 32, pn = n >> 8, T = n & 255, bj = T >> 7, cc = T & 127;
            tr_item(w_gu, 2 * DFF, bj * DFF + 128 * pn + cc, kb * 64, WguT, DM, n, ln2, scr, F.lane); continue; } r -= I_GU;
        { const int kb = r / 32, nb = r % 32; tr_item(w_d, DM, nb * 32, kb * 64, WdT, DFF, nb * 32, nullptr, scr, F.lane); }
    }
    __syncthreads();
    const int fr = F.lane & 15, fq = F.lane >> 4;
    for (int grp = gw; grp < MT / 16; grp += NGW) {
        const int row = grp * 16 + fr;
        const float* xr = (row < MP ? xp + (size_t)row * DM : xs + (size_t)(row - MP) * DM) + 8 * fq;
        bf16* xo = XN + (size_t)row * DM + 8 * fq;
        f32x4 acc = {0.f, 0.f, 0.f, 0.f}; float ss = 0.f;
#pragma unroll 4
        for (int s = 0; s < 32; ++s) {
            const f32x4 a = *(const f32x4*)(xr + 32 * s), b = *(const f32x4*)(xr + 32 * s + 4);
            ss += (a.x * a.x + a.y * a.y) + (a.z * a.z + a.w * a.w) + (b.x * b.x + b.y * b.y) + (b.z * b.z + b.w * b.w);
            u32x4 hw; hw.x = pk2(a.x, a.y); hw.y = pk2(a.z, a.w); hw.z = pk2(b.x, b.y); hw.w = pk2(b.z, b.w);
            *(u32x4*)(xo + 32 * s) = hw;
            u32x4 lw; lw.x = pk2(a.x - bflo(hw.x), a.y - bfhi(hw.x)); lw.y = pk2(a.z - bflo(hw.y), a.w - bfhi(hw.y)); lw.z = pk2(b.x - bflo(hw.z), b.y - bfhi(hw.z)); lw.w = pk2(b.z - bflo(hw.w), b.w - bfhi(hw.w));
            const bf16x8 wh = *(const LAS bf16x8*)(W16h + (((s * 4 + fq) * 16 + fr) << 3)), wl = *(const LAS bf16x8*)(W16l + (((s * 4 + fq) * 16 + fr) << 3));
            const bf16x8 xh = __builtin_bit_cast(bf16x8, hw), xl = __builtin_bit_cast(bf16x8, lw);
            acc = __builtin_amdgcn_mfma_f32_16x16x32_bf16(wh, xh, acc, 0, 0, 0);
            acc = __builtin_amdgcn_mfma_f32_16x16x32_bf16(wh, xl, acc, 0, 0, 0);
            acc = __builtin_amdgcn_mfma_f32_16x16x32_bf16(wl, xh, acc, 0, 0, 0);
        }
        ss += __shfl_xor(ss, 16); ss += __shfl_xor(ss, 32);
        const float rstd = rsqrtf(ss * (1.f / DM) + EPS);
        if (fq == 0) RSTD1[row] = rstd;
        if (fq < 2) { f32x4 o; o.x = sigmoidf_(acc.x * rstd); o.y = sigmoidf_(acc.y * rstd); o.z = sigmoidf_(acc.z * rstd); o.w = sigmoidf_(acc.w * rstd); *(f32x4*)(BETA + (size_t)row * 8 + 4 * fq) = o; }
        else { const int h0 = 4 * (fq - 2); f32x4 o;
#pragma unroll
            for (int i = 0; i < 4; ++i) { const float z = acc[i] * rstd + dt_bias[h0 + i]; const float sp = z > 20.f ? z : log1pf(__expf(z)); o[i] = -__expf(a_log[h0 + i]) * sp; }
            *(f32x4*)(GARR + (size_t)row * 8 + h0) = o; }
    }
}

namespace pg8 {
struct PairOrder {
    int G, c;
    __device__ bool next(int i, Unit& u) const { const int P = (i >> 1) * G + c; if (P >= 130 * 4) return false; const int s = i & 1; u.pm = (P >> 2) + 130 * s; u.pn = (P & 3) + 4 * s; return true; }
    __device__ __forceinline__ void a_ready(const Unit&) const {}
    __device__ __forceinline__ void done(const Unit&) const {}
};

struct EpiZ {
    static constexpr bool PERM = true, AFTER_DRAIN = false;
    unsigned char* ws; float* out;
    __device__ __forceinline__ void operator()(const f32x4 (&acc)[2][2][4][2], const Unit& u, int wr, int wc, int fr, int fq) const {
        const int pn = u.pn, row0 = u.pm * BM + wr * 64 + fr;
        const float* rstd = (const float*)(ws + WS_RSTD1);
        f32x4 wv[2][2];
        if (pn < 8) { const float* w = (const float*)(ws + WS_QKW) + (pn < 4 ? 0 : 64); const float sc = pn < 4 ? QSCALE : 1.f;
#pragma unroll
            for (int bj = 0; bj < 2; ++bj)
#pragma unroll
                for (int n = 0; n < 2; ++n) wv[bj][n] = *(const f32x4*)(w + 32 * bj + 8 * fq + 4 * n) * sc; }
#pragma unroll
        for (int ai = 0; ai < 2; ++ai)
#pragma unroll
            for (int m = 0; m < 4; ++m) {
                const int row = row0 + ai * HALF + m * 16; const float rs = rstd[row];
                f32x4 v[2][2];
#pragma unroll
                for (int bj = 0; bj < 2; ++bj)
#pragma unroll
                    for (int n = 0; n < 2; ++n) v[bj][n] = acc[ai][bj][m][n] * rs;
                const int lc = 64 * wc + 8 * fq;
                if (pn < 8) {
                    float ss = 0.f;
#pragma unroll
                    for (int bj = 0; bj < 2; ++bj)
#pragma unroll
                        for (int n = 0; n < 2; ++n) ss += (v[bj][n].x * v[bj][n].x + v[bj][n].y * v[bj][n].y) + (v[bj][n].z * v[bj][n].z + v[bj][n].w * v[bj][n].w);
                    ss += __shfl_xor(ss, 16); ss += __shfl_xor(ss, 32);
                    const float r = rsqrtf(ss * (1.f / 64.f) + EPS);
                    bf16_t* dst = (bf16_t*)(ws + (pn < 4 ? WS_QB : WS_KB)) + (size_t)row * DM + (pn & 3) * 256 + lc;
                    float* ko = out + (row < MP ? OFF_KP + (size_t)row * DM : OFF_KS + (size_t)(row - MP) * DM) + (pn & 3) * 256 + lc;
#pragma unroll
                    for (int bj = 0; bj < 2; ++bj) { const f32x4 o0 = v[bj][0] * r * wv[bj][0], o1 = v[bj][1] * r * wv[bj][1];
                        u32x4 w; w.x = pk2(o0.x, o0.y); w.y = pk2(o0.z, o0.w); w.z = pk2(o1.x, o1.y); w.w = pk2(o1.z, o1.w);
                        *(u32x4*)(dst + 32 * bj) = w;
                        if (pn >= 4) { *(f32x4*)(ko + 32 * bj) = o0; *(f32x4*)(ko + 32 * bj + 4) = o1; } }
                } else if (pn < 12) {
                    bf16_t* dst = (bf16_t*)(ws + WS_VB) + (size_t)row * DM + (pn - 8) * 256 + lc;
                    float* vo = out + (row < MP ? OFF_VP + (size_t)row * DM : OFF_VS + (size_t)(row - MP) * DM) + (pn - 8) * 256 + lc;
#pragma unroll
                    for (int bj = 0; bj < 2; ++bj) { u32x4 w; w.x = pk2(v[bj][0].x, v[bj][0].y); w.y = pk2(v[bj][0].z, v[bj][0].w); w.z = pk2(v[bj][1].x, v[bj][1].y); w.w = pk2(v[bj][1].z, v[bj][1].w);
                        *(u32x4*)(dst + 32 * bj) = w; *(f32x4*)(vo + 32 * bj) = v[bj][0]; *(f32x4*)(vo + 32 * bj + 4) = v[bj][1]; }
                } else if (pn < 24) {
                    const int col = (pn - 12) * 256 + lc; bf16_t* dst = (bf16_t*)(ws + WS_DQKV) + (size_t)row * CONVCH + col;
                    int cr = -1; float* co = nullptr;
                    if (row < MP) { const int t = row & (SEQ - 1); if (t >= SEQ - 3) { cr = t - (SEQ - 3); co = out + OFF_CP + ((size_t)(row >> 11) * 3 + cr) * CONVCH + col; } }
                    else { const int t = (row - MP) & (DSEQ - 1); if (t >= DSEQ - 3) { cr = t - (DSEQ - 3); co = out + OFF_CS + ((size_t)((row - MP) >> 5) * 3 + cr) * CONVCH + col; } }
#pragma unroll
                    for (int bj = 0; bj < 2; ++bj) { u32x4 w; w.x = pk2(v[bj][0].x, v[bj][0].y); w.y = pk2(v[bj][0].z, v[bj][0].w); w.z = pk2(v[bj][1].x, v[bj][1].y); w.w = pk2(v[bj][1].z, v[bj][1].w);
                        *(u32x4*)(dst + 32 * bj) = w; if (cr >= 0) { *(f32x4*)(co + 32 * bj) = v[bj][0]; *(f32x4*)(co + 32 * bj + 4) = v[bj][1]; } }
                } else {
                    bf16_t* dst = (bf16_t*)(ws + (pn < 28 ? WS_DG : (pn < 32 ? WS_GA : WS_GB))) + (size_t)row * DM + (pn & 3) * 256 + lc;
                    const bool sg = pn >= 28;
#pragma unroll
                    for (int bj = 0; bj < 2; ++bj) { f32x4 a = v[bj][0], b = v[bj][1];
                        if (sg) { a.x = sigmoidf_(a.x); a.y = sigmoidf_(a.y); a.z = sigmoidf_(a.z); a.w = sigmoidf_(a.w); b.x = sigmoidf_(b.x); b.y = sigmoidf_(b.y); b.z = sigmoidf_(b.z); b.w = sigmoidf_(b.w); }
                        u32x4 w; w.x = pk2(a.x, a.y); w.y = pk2(a.z, a.w); w.z = pk2(b.x, b.y); w.w = pk2(b.z, b.w); *(u32x4*)(dst + 32 * bj) = w; }
                }
                asm volatile("" ::: "memory");
            }
    }
};

struct EpiAB {
    static constexpr bool PERM = true, AFTER_DRAIN = false;
    unsigned char* ws; float* tmp;
    __device__ __forceinline__ void operator()(const f32x4 (&acc)[2][2][4][2], const Unit& u, int wr, int wc, int fr, int fq) const {
        const int s = u.pm >= 130 ? 1 : 0; const int pm = u.pm - 130 * s, pn = u.pn - 4 * s;
        const int row0 = pm * BM + wr * 64 + fr, col0 = pn * BM + wc * 32 + 8 * fq;
        const bf16_t* G = (const bf16_t*)(ws + (s ? WS_GB : WS_GA)); bf16_t* MERGED = (bf16_t*)(ws + WS_MERGED);
#pragma unroll
        for (int ai = 0; ai < 2; ++ai)
#pragma unroll
            for (int m = 0; m < 4; ++m) { const size_t off = (size_t)(row0 + ai * HALF + m * 16) * DM + col0;
#pragma unroll
                for (int bj = 0; bj < 2; ++bj) { const u32x4 g = *(const u32x4*)(G + off + bj * HALF);
                    f32x4 a = acc[ai][bj][m][0], b = acc[ai][bj][m][1];
                    a.x *= bflo(g.x); a.y *= bfhi(g.x); a.z *= bflo(g.y); a.w *= bfhi(g.y); b.x *= bflo(g.z); b.y *= bfhi(g.z); b.z *= bflo(g.w); b.w *= bfhi(g.w);
                    float* t = tmp + off + bj * HALF;
                    if (s == 0) { *(f32x4*)t = a; *(f32x4*)(t + 4) = b; }
                    else { a += *(const f32x4*)t; b += *(const f32x4*)(t + 4); u32x4 w; w.x = pk2(a.x, a.y); w.y = pk2(a.z, a.w); w.z = pk2(b.x, b.y); w.w = pk2(b.z, b.w); *(u32x4*)(MERGED + off + bj * HALF) = w; } } }
    }
};

struct EpiOut {
    static constexpr bool PERM = true, AFTER_DRAIN = false;
    const float* xp; const float* xs; float* out; bf16_t* X1B; float* RSS;
    __device__ __forceinline__ void operator()(const f32x4 (&acc)[2][2][4][2], const Unit& u, int wr, int wc, int fr, int fq) const {
        const int row0 = u.pm * BM + wr * 64 + fr, col0 = u.pn * BM + wc * 32 + 8 * fq;
#pragma unroll
        for (int ai = 0; ai < 2; ++ai)
#pragma unroll
            for (int m = 0; m < 4; ++m) { const int row = row0 + ai * HALF + m * 16; const size_t off = (size_t)row * DM + col0;
                const float* xr = (row < MP ? xp + (size_t)row * DM : xs + (size_t)(row - MP) * DM) + col0; float ss = 0.f;
#pragma unroll
                for (int bj = 0; bj < 2; ++bj) { const f32x4 a = acc[ai][bj][m][0] + *(const f32x4*)(xr + bj * HALF), b = acc[ai][bj][m][1] + *(const f32x4*)(xr + bj * HALF + 4);
                    ss += (a.x * a.x + a.y * a.y) + (a.z * a.z + a.w * a.w) + (b.x * b.x + b.y * b.y) + (b.z * b.z + b.w * b.w);
                    *(f32x4*)(out + off + bj * HALF) = a; *(f32x4*)(out + off + bj * HALF + 4) = b;
                    u32x4 w; w.x = pk2(a.x, a.y); w.y = pk2(a.z, a.w); w.z = pk2(b.x, b.y); w.w = pk2(b.z, b.w); *(u32x4*)(X1B + off + bj * HALF) = w; }
                ss += __shfl_xor(ss, 16); ss += __shfl_xor(ss, 32);
                if (fq == 0) RSS[(size_t)row * 16 + u.pn * 4 + wc] = ss; }
    }
};

struct EpiGU {
    static constexpr bool PERM = true, AFTER_DRAIN = false;
    const float* RSS; bf16_t* ACT;
    __device__ __forceinline__ void operator()(const f32x4 (&acc)[2][2][4][2], const Unit& u, int wr, int wc, int fr, int fq) const {
        const int row0 = u.pm * BM + wr * 64 + fr, col0 = u.pn * 128 + wc * 32 + 8 * fq;
#pragma unroll
        for (int ai = 0; ai < 2; ++ai)
#pragma unroll
            for (int m = 0; m < 4; ++m) { const int row = row0 + ai * HALF + m * 16;
                const f32x4* rp = (const f32x4*)(RSS + (size_t)row * 16); const f32x4 r0 = rp[0], r1 = rp[1], r2 = rp[2], r3 = rp[3];
                const float ss = ((r0.x + r0.y) + (r0.z + r0.w)) + ((r1.x + r1.y) + (r1.z + r1.w)) + ((r2.x + r2.y) + (r2.z + r2.w)) + ((r3.x + r3.y) + (r3.z + r3.w));
                const float rs = rsqrtf(ss * (1.f / DM) + EPS);
                f32x4 o[2];
#pragma unroll
                for (int n = 0; n < 2; ++n) { const f32x4 g = acc[ai][0][m][n] * rs, uu = acc[ai][1][m][n] * rs;
                    o[n].x = g.x * sigmoidf_(g.x) * uu.x; o[n].y = g.y * sigmoidf_(g.y) * uu.y; o[n].z = g.z * sigmoidf_(g.z) * uu.z; o[n].w = g.w * sigmoidf_(g.w) * uu.w; }
                u32x4 w; w.x = pk2(o[0].x, o[0].y); w.y = pk2(o[0].z, o[0].w); w.z = pk2(o[1].x, o[1].y); w.w = pk2(o[1].z, o[1].w);
                *(u32x4*)(ACT + (size_t)row * DFF + col0) = w; }
    }
};

struct EpiDown {
    static constexpr bool PERM = true, AFTER_DRAIN = false;
    float* out;
    __device__ __forceinline__ void operator()(const f32x4 (&acc)[2][2][4][2], const Unit& u, int wr, int wc, int fr, int fq) const {
        const int row0 = u.pm * BM + wr * 64 + fr, col0 = u.pn * BM + wc * 32 + 8 * fq;
#pragma unroll
        for (int ai = 0; ai < 2; ++ai)
#pragma unroll
            for (int m = 0; m < 4; ++m) { float* o = out + (size_t)(row0 + ai * HALF + m * 16) * DM + col0;
#pragma unroll
                for (int bj = 0; bj < 2; ++bj) { *(f32x4*)(o + bj * HALF) = *(const f32x4*)(o + bj * HALF) + acc[ai][bj][m][0]; *(f32x4*)(o + bj * HALF + 4) = *(const f32x4*)(o + bj * HALF + 4) + acc[ai][bj][m][1]; } }
    }
};
}

__device__ __forceinline__ float lambda_of(const Frame& F) {
    const float* q1 = F.in[10]; const float* k1 = F.in[11]; const float* q2 = F.in[12]; const float* k2 = F.in[13];
    float a = 0.f, b = 0.f;
    for (int i = 0; i < 64; ++i) { a += q1[i] * k1[i]; b += q2[i] * k2[i]; }
    return __expf(a) - __expf(b) + LAM_INIT;
}

__device__ __forceinline__ void conv_task(const Frame& F, int task) {
    const bf16* DQKV = (const bf16*)(F.ws + WS_DQKV); bf16* QKVC = (bf16*)(F.ws + WS_QKVC);
    const float* conv_w = F.in[16]; const float* sconv = F.in[5];
    int lane_ = F.lane; asm volatile("" : "+v"(lane_)); const int run = task / 6, cgp = task % 6; const int c0 = cgp * 512 + lane_ * 8; const int r0 = run * 32;
    const bool sample = r0 >= MP; const int t0 = sample ? 0 : (r0 & (SEQ - 1));
    float w[4][8];
#pragma unroll
    for (int j = 0; j < 4; ++j) { const f32x4 a = *(const f32x4*)(conv_w + j * CONVCH + c0), b = *(const f32x4*)(conv_w + j * CONVCH + c0 + 4); w[j][0] = a.x; w[j][1] = a.y; w[j][2] = a.z; w[j][3] = a.w; w[j][4] = b.x; w[j][5] = b.y; w[j][6] = b.z; w[j][7] = b.w; }
    float h[3][8];
#pragma unroll
    for (int j = 0; j < 3; ++j) {
        if (t0 > 0) { const u32x4 v = *(const u32x4*)(DQKV + (size_t)(r0 - 3 + j) * CONVCH + c0); h[j][0] = bflo(v.x); h[j][1] = bfhi(v.x); h[j][2] = bflo(v.y); h[j][3] = bfhi(v.y); h[j][4] = bflo(v.z); h[j][5] = bfhi(v.z); h[j][6] = bflo(v.w); h[j][7] = bfhi(v.w); }
        else if (sample) { const float* s = sconv + ((size_t)((r0 - MP) >> 5) * 3 + j) * CONVCH + c0; const f32x4 a = *(const f32x4*)s, b = *(const f32x4*)(s + 4); h[j][0] = a.x; h[j][1] = a.y; h[j][2] = a.z; h[j][3] = a.w; h[j][4] = b.x; h[j][5] = b.y; h[j][6] = b.z; h[j][7] = b.w; }
        else {
#pragma unroll
            for (int e = 0; e < 8; ++e) h[j][e] = 0.f; }
    }
    const float qs = cgp < 2 ? 0.08838834764831845f : 1.f; const bool nrm = cgp < 4;
    for (int t = 0; t < 32; ++t) {
        const u32x4 v = *(const u32x4*)(DQKV + (size_t)(r0 + t) * CONVCH + c0);
        float x[8]; x[0] = bflo(v.x); x[1] = bfhi(v.x); x[2] = bflo(v.y); x[3] = bfhi(v.y); x[4] = bflo(v.z); x[5] = bfhi(v.z); x[6] = bflo(v.w); x[7] = bfhi(v.w);
        float y[8]; float ss = 0.f;
#pragma unroll
        for (int e = 0; e < 8; ++e) { float a = w[0][e] * h[0][e] + w[1][e] * h[1][e] + w[2][e] * h[2][e] + w[3][e] * x[e]; a = a * sigmoidf_(a); y[e] = a; ss += a * a; h[0][e] = h[1][e]; h[1][e] = h[2][e]; h[2][e] = x[e]; }
        if (nrm) { ss += __shfl_xor(ss, 1); ss += __shfl_xor(ss, 2); ss += __shfl_xor(ss, 4); ss += __shfl_xor(ss, 8); const float r = rsqrtf(ss + EPS) * qs;
#pragma unroll
            for (int e = 0; e < 8; ++e) y[e] *= r; }
        u32x4 o; o.x = pk2(y[0], y[1]); o.y = pk2(y[2], y[3]); o.z = pk2(y[4], y[5]); o.w = pk2(y[6], y[7]);
        *(u32x4*)(QKVC + (size_t)(r0 + t) * CONVCH + c0) = o;
    }
}

__device__ __forceinline__ int swz_f(int r) { return ((r & 3) << 2) | ((r >> 2) & 3); }
__device__ __forceinline__ int tile_off(int r, int ch) { return 256 * r + 16 * (ch ^ swz_f(r)); }
__device__ __forceinline__ s16x4 vtr(const LAS unsigned char* p) { typedef short v4i16_t __attribute__((ext_vector_type(4))); return __builtin_bit_cast(s16x4, __builtin_amdgcn_ds_read_tr16_b64_v4i16((LAS v4i16_t*)p)); }
__device__ __forceinline__ float exp2_(float x) { return __builtin_amdgcn_exp2f(x); }

__device__ __forceinline__ f32x16 qk_block(const LAS unsigned char* KT, int kb, int m, const bf16x8 (&qf)[4], int r, int hh) {
    f32x16 s = {0.f, 0.f, 0.f, 0.f, 0.f, 0.f, 0.f, 0.f, 0.f, 0.f, 0.f, 0.f, 0.f, 0.f, 0.f, 0.f};
    const int key = 32 * kb + r; const int fz = swz_f(key);
#pragma unroll
    for (int d0 = 0; d0 < 4; ++d0) { const bf16x8 kf = *(const LAS bf16x8*)(KT + 256 * key + 16 * ((8 * m + 2 * d0 + hh) ^ fz)); s = __builtin_amdgcn_mfma_f32_32x32x16_bf16(kf, qf[d0], s, 0, 0, 0); }
    return s;
}
__device__ __forceinline__ float exp_block(f32x16& s) { float a = 0.f;
#pragma unroll
    for (int i = 0; i < 16; ++i) { s[i] = exp2_(s[i]); a += s[i]; }
    return a; }
__device__ __forceinline__ bf16x8 pfrag(const f32x16& p, int s) { u32x4 w; w.x = pk2(p[8 * s + 0], p[8 * s + 1]); w.y = pk2(p[8 * s + 2], p[8 * s + 3]); w.z = pk2(p[8 * s + 4], p[8 * s + 5]); w.w = pk2(p[8 * s + 6], p[8 * s + 7]); return __builtin_bit_cast(bf16x8, w); }
__device__ __forceinline__ bf16x8 vfrag(const LAS unsigned char* VT, int eb, int kb, int s, int lane) {
    const int hh = lane >> 5, gsel = (lane >> 4) & 1, q = (lane >> 2) & 3, p = lane & 3;
    const int row = 32 * kb + 16 * s + 4 * hh + q; const int ch = 4 * eb + 2 * gsel + (p >> 1);
    const s16x4 lo = vtr(VT + 256 * row + 16 * (ch ^ swz_f(row)) + 8 * (p & 1));
    const s16x4 hi = vtr(VT + 256 * (row + 8) + 16 * (ch ^ swz_f(row + 8)) + 8 * (p & 1));
    return (bf16x8){lo[0], lo[1], lo[2], lo[3], hi[0], hi[1], hi[2], hi[3]};
}

template <int BUF> __device__ __forceinline__ void attn_tile(const LAS unsigned char* L, f32x16 (&O)[4], float& l, const bf16x8 (&qf)[4], int krow, int fzm, const int (&vb)[4][2]) {
    const LAS unsigned char* KT = L + BUF * 32768; const LAS unsigned char* VT = KT + 16384;
    bf16x8 p[2][2];
#pragma unroll
    for (int kb = 0; kb < 2; ++kb) {
        f32x16 s;
#pragma unroll
        for (int i = 0; i < 16; ++i) s[i] = 0.f;
#pragma unroll
        for (int d0 = 0; d0 < 4; ++d0) { const bf16x8 kf = *(const LAS bf16x8*)(KT + krow + 8192 * kb + 16 * ((2 * d0) ^ fzm)); s = __builtin_amdgcn_mfma_f32_32x32x16_bf16(kf, qf[d0], s, 0, 0, 0); }
        l += exp_block(s);
        p[kb][0] = pfrag(s, 0); p[kb][1] = pfrag(s, 1);
    }
#pragma unroll
    for (int eb = 0; eb < 4; ++eb) {
#pragma unroll
        for (int kb = 0; kb < 2; ++kb)
#pragma unroll
            for (int s = 0; s < 2; ++s) {
                const s16x4 lo = vtr(VT + vb[eb][0] + 8192 * kb + 4096 * s), hi = vtr(VT + vb[eb][1] + 8192 * kb + 4096 * s);
                O[eb] = __builtin_amdgcn_mfma_f32_32x32x16_bf16((bf16x8){lo[0], lo[1], lo[2], lo[3], hi[0], hi[1], hi[2], hi[3]}, p[kb][s], O[eb], 0, 0, 0); }
    }
}
__device__ __forceinline__ void attn_prompt_unit(const Frame& F, int b, int h, int qb, float lam) {
    const bf16* Qb = (const bf16*)(F.ws + WS_QB); const bf16* Kb = (const bf16*)(F.ws + WS_KB); const bf16* Vb = (const bf16*)(F.ws + WS_VB); bf16* OA = (bf16*)(F.ws + WS_OAB);
    const float* subw = F.in[14];
    int lane = F.lane; asm volatile("" : "+v"(lane)); const int w = F.wave, r = lane & 31, hh = lane >> 5, g = w & 3, m = w >> 2;
    const size_t rowbase = (size_t)b * SEQ; const int q0 = 128 * qb + 32 * g;
    const int NT = 2 * qb + 2, tmax = 2 * qb + (g >> 1);
    const LAS unsigned char* L = F.lds;
    bf16x8 qf[4];
#pragma unroll
    for (int d0 = 0; d0 < 4; ++d0) qf[d0] = *(const bf16x8*)(Qb + (rowbase + q0 + r) * DM + h * 128 + m * 64 + 16 * d0 + 8 * hh);
    const int fzm = swz_f(r) ^ hh ^ (8 * m); const int krow = 256 * r;
    int vb[4][2];
    { const int gsel = (lane >> 4) & 1, q = (lane >> 2) & 3, p = lane & 3;
#pragma unroll
      for (int eb = 0; eb < 4; ++eb)
#pragma unroll
          for (int hl = 0; hl < 2; ++hl) { const int row = 4 * hh + q + 8 * hl; vb[eb][hl] = 256 * row + 16 * ((4 * eb + 2 * gsel + (p >> 1)) ^ swz_f(row)) + 8 * (p & 1); } }
    f32x16 O[4];
#pragma unroll
    for (int eb = 0; eb < 4; ++eb)
#pragma unroll
        for (int i = 0; i < 16; ++i) O[eb][i] = 0.f;
    float l = 0.f;
    const bf16* kg[2]; const bf16* vg[2];
#pragma unroll
    for (int i = 0; i < 2; ++i) { const int row = 4 * (2 * w + i) + (lane >> 4), ch = (lane & 15) ^ swz_f(row); kg[i] = Kb + (rowbase + row) * DM + h * 128 + ch * 8; vg[i] = Vb + (rowbase + row) * DM + h * 128 + ch * 8; }
#define STAGE_T(t, BUF) do { const size_t o_ = (size_t)(t) * 64 * DM; _Pragma("unroll") for (int i_ = 0; i_ < 2; ++i_) { \
        __builtin_amdgcn_global_load_lds((const unsigned*)(kg[i_] + o_), (LAS unsigned*)(F.lds + (BUF) * 32768 + (2 * w + i_) * 1024), 16, 0, 0); \
        __builtin_amdgcn_global_load_lds((const unsigned*)(vg[i_] + o_), (LAS unsigned*)(F.lds + (BUF) * 32768 + 16384 + (2 * w + i_) * 1024), 16, 0, 0); } } while (0)
    __syncthreads();
    STAGE_T(0, 0);
    __syncthreads();
    for (int t = 0; t < NT; t += 2) {
        STAGE_T(t + 1, 1);
        if (t <= tmax) attn_tile<0>(L, O, l, qf, krow, fzm, vb);
        __syncthreads();
        if (t + 2 < NT) STAGE_T(t + 2, 0);
        if (t + 1 <= tmax) attn_tile<1>(L, O, l, qf, krow, fzm, vb);
        __syncthreads();
    }
#undef STAGE_T
    l += __shfl_xor(l, 32);
    LAS float* X = (LAS float*)(F.lds + 65536 + g * 16384);
    if (m == 1) { const float i1 = lam / l;
#pragma unroll
        for (int eb = 0; eb < 4; ++eb)
#pragma unroll
            for (int i = 0; i < 16; ++i) X[(eb * 16 + i) * 64 + lane] = O[eb][i] * i1; }
    __syncthreads();
    if (m == 0) { const float i0 = 1.f / l; float ss = 0.f;
#pragma unroll
        for (int eb = 0; eb < 4; ++eb)
#pragma unroll
            for (int i = 0; i < 16; ++i) { const float o = O[eb][i] * i0 - X[(eb * 16 + i) * 64 + lane]; O[eb][i] = o; ss += o * o; }
        ss += __shfl_xor(ss, 32);
        const float rs = rsqrtf(ss * (1.f / 128.f) + EPS) * (1.f - LAM_INIT);
        bf16* orow = OA + (rowbase + q0 + r) * DM + h * 128;
#pragma unroll
        for (int eb = 0; eb < 4; ++eb)
#pragma unroll
            for (int g4 = 0; g4 < 4; ++g4) { const int e = 32 * eb + 8 * g4 + 4 * hh; const f32x4 sw = *(const f32x4*)(subw + e);
                u32x2 o; o.x = pk2(O[eb][4 * g4 + 0] * rs * sw.x, O[eb][4 * g4 + 1] * rs * sw.y); o.y = pk2(O[eb][4 * g4 + 2] * rs * sw.z, O[eb][4 * g4 + 3] * rs * sw.w);
                *(u32x2*)(orow + e) = o; } }
}

__device__ __forceinline__ void attn_sample_unit(const Frame& F, int b, int h, int sp) {
    const bf16* Qb = (const bf16*)(F.ws + WS_QB); const bf16* Kb = (const bf16*)(F.ws + WS_KB); const bf16* Vb = (const bf16*)(F.ws + WS_VB);
    const float* ck = F.in[2]; const float* cv = F.in[3];
    float* PARTO = (float*)(F.ws + WS_PARTO); float* PARTL = (float*)(F.ws + WS_PARTL);
    int lane = F.lane; asm volatile("" : "+v"(lane)); const int w = F.wave, r = lane & 31, hh = lane >> 5, m = w >> 2, eb = w & 3;
    bf16x8 qf[4];
#pragma unroll
    for (int d0 = 0; d0 < 4; ++d0) qf[d0] = *(const bf16x8*)(Qb + (size_t)(MP + b * DSEQ + r) * DM + h * 128 + m * 64 + 16 * d0 + 8 * hh);
    f32x16 O;
#pragma unroll
    for (int i = 0; i < 16; ++i) O[i] = 0.f;
    float l = 0.f;
    int tid_ = F.tid; asm volatile("" : "+v"(tid_)); const int pr0 = tid_ >> 4, pc = tid_ & 15;
    const int so0 = tile_off(pr0, pc), so1 = tile_off(pr0 + 32, pc);
    const size_t pos0 = (size_t)sp * 2048;
    const float* kg = ck + (((size_t)b * PAST + pos0 + pr0) * NH + h) * 128 + pc * 8; const float* vg = cv + (((size_t)b * PAST + pos0 + pr0) * NH + h) * 128 + pc * 8;
    constexpr size_t RS = (size_t)NH * 128;
    constexpr int NTC = 32;
    const int NT = NTC + (sp == 1 ? 1 : 0);
    f32x4 sk[4], sv[4];
#define LOADC(t) do { const size_t o_ = (size_t)(t) * 64 * RS; sk[0] = *(const f32x4*)(kg + o_); sk[1] = *(const f32x4*)(kg + o_ + 4); sk[2] = *(const f32x4*)(kg + o_ + 32 * RS); sk[3] = *(const f32x4*)(kg + o_ + 32 * RS + 4); \
        sv[0] = *(const f32x4*)(vg + o_); sv[1] = *(const f32x4*)(vg + o_ + 4); sv[2] = *(const f32x4*)(vg + o_ + 32 * RS); sv[3] = *(const f32x4*)(vg + o_ + 32 * RS + 4); } while (0)
#define PK8(a, b_) ((u32x4){pk2((a).x, (a).y), pk2((a).z, (a).w), pk2((b_).x, (b_).y), pk2((b_).z, (b_).w)})
#define STOREC(buf) do { LAS unsigned char* K_ = F.lds + (buf) * 32768; LAS unsigned char* V_ = K_ + 16384; \
        *(LAS u32x4*)(K_ + so0) = PK8(sk[0], sk[1]); *(LAS u32x4*)(K_ + so1) = PK8(sk[2], sk[3]); *(LAS u32x4*)(V_ + so0) = PK8(sv[0], sv[1]); *(LAS u32x4*)(V_ + so1) = PK8(sv[2], sv[3]); } while (0)
    LOADC(0);
    __syncthreads();
    STOREC(0);
    __syncthreads();
    for (int t = 0; t < NT; ++t) {
        const bool more_c = t + 1 < NTC, more_n = (t + 1 == NTC) && (sp == 1);
        u32x4 nk, nv;
        if (more_c) LOADC(t + 1);
        if (more_n) { nk = *(const u32x4*)(Kb + (size_t)(MP + b * DSEQ + pr0) * DM + h * 128 + pc * 8); nv = *(const u32x4*)(Vb + (size_t)(MP + b * DSEQ + pr0) * DM + h * 128 + pc * 8); }
        const LAS unsigned char* KT = F.lds + (t & 1) * 32768; const LAS unsigned char* VT = KT + 16384;
        const int nkb = t < NTC ? 2 : 1;
        {
            f32x16 s0 = qk_block(KT, 0, m, qf, r, hh);
            l += exp_block(s0);
            O = __builtin_amdgcn_mfma_f32_32x32x16_bf16(vfrag(VT, eb, 0, 0, lane), pfrag(s0, 0), O, 0, 0, 0);
            O = __builtin_amdgcn_mfma_f32_32x32x16_bf16(vfrag(VT, eb, 0, 1, lane), pfrag(s0, 1), O, 0, 0, 0);
            if (nkb == 2) {
                f32x16 s1 = qk_block(KT, 1, m, qf, r, hh);
                l += exp_block(s1);
                O = __builtin_amdgcn_mfma_f32_32x32x16_bf16(vfrag(VT, eb, 1, 0, lane), pfrag(s1, 0), O, 0, 0, 0);
                O = __builtin_amdgcn_mfma_f32_32x32x16_bf16(vfrag(VT, eb, 1, 1, lane), pfrag(s1, 1), O, 0, 0, 0);
            }
        }
        if (more_c) STOREC((t + 1) & 1);
        if (more_n) { LAS unsigned char* K_ = F.lds + ((t + 1) & 1) * 32768; LAS unsigned char* V_ = K_ + 16384; *(LAS u32x4*)(K_ + so0) = nk; *(LAS u32x4*)(V_ + so0) = nv; }
        __syncthreads();
    }
#undef LOADC
#undef PK8
#undef STOREC
    l += __shfl_xor(l, 32);
    const size_t pidx = (((size_t)(b * NH + h) * 2 + sp) * 2 + m);
    float* po = PARTO + pidx * 4096;
#pragma unroll
    for (int i = 0; i < 16; ++i) { const int e = 32 * eb + (i & 3) + 8 * (i >> 2) + 4 * hh; po[e * 32 + r] = O[i]; }
    if (eb == 0 && hh == 0) PARTL[pidx * 32 + r] = l;
}

__device__ __forceinline__ void attn_sample_combine(const Frame& F, int b, int h, float lam) {
    const float* PARTO = (const float*)(F.ws + WS_PARTO); const float* PARTL = (const float*)(F.ws + WS_PARTL); bf16* OA = (bf16*)(F.ws + WS_OAB); const float* subw = F.in[14];
    LAS float* red = (LAS float*)F.lds;
    int tid_ = F.tid; asm volatile("" : "+v"(tid_)); const int q = tid_ & 31, eg = tid_ >> 5, e0 = eg * 8;
    const size_t p00 = ((size_t)(b * NH + h) * 2 + 0) * 2, p10 = ((size_t)(b * NH + h) * 2 + 1) * 2;
    const float l0 = PARTL[(p00 + 0) * 32 + q] + PARTL[(p10 + 0) * 32 + q], l1 = PARTL[(p00 + 1) * 32 + q] + PARTL[(p10 + 1) * 32 + q];
    const float i0 = 1.f / l0, i1 = lam / l1;
    float o[8]; float ss = 0.f;
#pragma unroll
    for (int i = 0; i < 8; ++i) { const int e = e0 + i;
        const float a = PARTO[(p00 + 0) * 4096 + e * 32 + q] + PARTO[(p10 + 0) * 4096 + e * 32 + q], c = PARTO[(p00 + 1) * 4096 + e * 32 + q] + PARTO[(p10 + 1) * 4096 + e * 32 + q];
        o[i] = a * i0 - c * i1; ss += o[i] * o[i]; }
    __syncthreads();
    red[q * 16 + eg] = ss;
    __syncthreads();
    float tot = 0.f;
#pragma unroll
    for (int i = 0; i < 16; ++i) tot += red[q * 16 + i];
    const float rs = rsqrtf(tot * (1.f / 128.f) + EPS) * (1.f - LAM_INIT);
    const f32x4 s0 = *(const f32x4*)(subw + e0), s1 = *(const f32x4*)(subw + e0 + 4);
    u32x4 ov; ov.x = pk2(o[0] * rs * s0.x, o[1] * rs * s0.y); ov.y = pk2(o[2] * rs * s0.z, o[3] * rs * s0.w); ov.z = pk2(o[4] * rs * s1.x, o[5] * rs * s1.y); ov.w = pk2(o[6] * rs * s1.z, o[7] * rs * s1.w);
    *(u32x4*)(OA + (size_t)(MP + b * DSEQ + q) * DM + h * 128 + e0) = ov;
}

__device__ __forceinline__ void delta_seq_unit(const Frame& F, int seq, int h) {
    const bf16* QKVC = (const bf16*)(F.ws + WS_QKVC); const float* BETA = (const float*)(F.ws + WS_BETA); const float* GARR = (const float*)(F.ws + WS_G);
    const bf16* DG = (const bf16*)(F.ws + WS_DG); bf16* OB = (bf16*)(F.ws + WS_OAB) + (size_t)MT * DM; const float* dnw = F.in[19];
    const bool sample = seq >= NB; const int L = sample ? DSEQ : SEQ; const size_t row0 = sample ? (size_t)MP + (size_t)(seq - NB) * DSEQ : (size_t)seq * SEQ;
    float* sout = F.out + (sample ? OFF_DS + ((size_t)(seq - NB) * NH + h) * 16384 : OFF_DP + ((size_t)seq * NH + h) * 16384);
    int tid = F.tid; asm volatile("" : "+v"(tid)); const int e = tid & 127, dq = tid >> 7;
    LAS float* Lq = (LAS float*)F.lds; LAS float* Lk = Lq + 4096; LAS float* Lv = Lk + 4096; LAS float* Lb = Lv + 4096; LAS float* Lg = Lb + 32; LAS float* Lqk = Lg + 32;
    LAS float* Lx = Lqk + 32; LAS float* Lo = Lx + 2048;
    float S[32];
    if (sample) { const float* s0 = F.in[4] + ((size_t)(seq - NB) * NH + h) * 16384;
#pragma unroll
        for (int i = 0; i < 32; ++i) S[i] = s0[(32 * dq + i) * 128 + e]; }
    else {
#pragma unroll
        for (int i = 0; i < 32; ++i) S[i] = 0.f; }
    for (int tb = 0; tb < L; tb += 32) {
        __syncthreads();
        { const int f = tid >> 4, c8 = (tid & 15) * 8; const bf16* src = QKVC + (row0 + tb + f) * CONVCH + h * 128 + c8;
#pragma unroll
          for (int part = 0; part < 3; ++part) { const u32x4 v = *(const u32x4*)(src + part * 1024); LAS float* d = (part == 0 ? Lq : part == 1 ? Lk : Lv) + f * 128 + c8;
              *(LAS f32x4*)d = (f32x4){bflo(v.x), bfhi(v.x), bflo(v.y), bfhi(v.y)}; *(LAS f32x4*)(d + 4) = (f32x4){bflo(v.z), bfhi(v.z), bflo(v.w), bfhi(v.w)}; }
          if (tid < 32) { Lb[tid] = BETA[(row0 + tb + tid) * 8 + h]; Lg[tid] = __expf(GARR[(row0 + tb + tid) * 8 + h]); } }
        __syncthreads();
        { const int f = tid >> 4, c8 = (tid & 15) * 8; float a = 0.f;
#pragma unroll
          for (int i = 0; i < 8; ++i) a += Lq[f * 128 + c8 + i] * Lk[f * 128 + c8 + i];
          a += __shfl_xor(a, 1); a += __shfl_xor(a, 2); a += __shfl_xor(a, 4); a += __shfl_xor(a, 8);
          if ((tid & 15) == 0) Lqk[f] = a; }
        __syncthreads();
        for (int f = 0; f < 32; ++f) {
            float pk = 0.f, pq = 0.f;
            const LAS f32x4* kp = (const LAS f32x4*)(Lk + f * 128 + 32 * dq); const LAS f32x4* qp = (const LAS f32x4*)(Lq + f * 128 + 32 * dq);
            float kr[32];
#pragma unroll
            for (int i4 = 0; i4 < 8; ++i4) { const f32x4 kv = kp[i4], qv = qp[i4];
                kr[4 * i4] = kv.x; kr[4 * i4 + 1] = kv.y; kr[4 * i4 + 2] = kv.z; kr[4 * i4 + 3] = kv.w;
                pk += kv.x * S[4 * i4] + kv.y * S[4 * i4 + 1] + kv.z * S[4 * i4 + 2] + kv.w * S[4 * i4 + 3];
                pq += qv.x * S[4 * i4] + qv.y * S[4 * i4 + 1] + qv.z * S[4 * i4 + 2] + qv.w * S[4 * i4 + 3]; }
            LAS float* X = Lx + (f & 1) * 1024;
            X[dq * 128 + e] = pk; X[512 + dq * 128 + e] = pq;
            __syncthreads();
            const float kS = (X[e] + X[128 + e]) + (X[256 + e] + X[384 + e]); const float qS = (X[512 + e] + X[640 + e]) + (X[768 + e] + X[896 + e]);
            const float eg = Lg[f], be = Lb[f];
            const float dl = be * (Lv[f * 128 + e] - eg * kS);
#pragma unroll
            for (int i = 0; i < 32; ++i) S[i] = eg * S[i] + kr[i] * dl;
            if (dq == 0) Lo[f * 128 + e] = eg * qS + Lqk[f] * dl;
        }
        __syncthreads();
        { const int w = F.wave, lane = F.lane;
#pragma unroll
          for (int ff = 0; ff < 4; ++ff) { const int f = 4 * w + ff; const float a = Lo[f * 128 + 2 * lane], c = Lo[f * 128 + 2 * lane + 1];
              const float ss = wave_sum(a * a + c * c); const float rs = rsqrtf(ss * (1.f / 128.f) + EPS);
              const unsigned gw_ = *(const unsigned*)(DG + (row0 + tb + f) * DM + h * 128 + 2 * lane); const float g0 = bflo(gw_), g1 = bfhi(gw_);
              const float o0 = a * rs * dnw[2 * lane] * (g0 * sigmoidf_(g0)), o1 = c * rs * dnw[2 * lane + 1] * (g1 * sigmoidf_(g1));
              *(unsigned*)(OB + (row0 + tb + f) * DM + h * 128 + 2 * lane) = pk2(o0, o1); } }
    }
#pragma unroll
    for (int i = 0; i < 32; ++i) sout[(32 * dq + i) * 128 + e] = S[i];
}

constexpr size_t WS_DW = 910 * MiB;
constexpr size_t WS_DAL = 976 * MiB;
constexpr size_t WS_DEG = 1009 * MiB;
constexpr size_t WS_DUT_P = 455 * MiB;
constexpr size_t WS_DUT_S = 1012 * MiB;
constexpr size_t WS_END2 = 1014 * MiB;
static_assert(WS_DUT_P >= WS_OAB + 130 * MiB && WS_DUT_P + 64 * MiB <= WS_QKVC && WS_DW >= WS_GB + 65 * MiB, "delta workspace map");
__device__ __forceinline__ bf16* dut_ptr(unsigned char* ws, size_t ch) { return (bf16*)(ws + (ch < 4096 ? WS_DUT_P + ch * 16384 : WS_DUT_S + (ch - 4096) * 16384)); }
constexpr int NCH = 528;

__device__ __forceinline__ void delta_chunk_unit(const Frame& F, int cu) {
    bf16* DW = (bf16*)(F.ws + WS_DW); bf16* DAL = (bf16*)(F.ws + WS_DAL); float* DEG = (float*)(F.ws + WS_DEG);
    const bf16* QKVC = (const bf16*)(F.ws + WS_QKVC); const float* BETA = (const float*)(F.ws + WS_BETA); const float* GARR = (const float*)(F.ws + WS_G);
    int lane = F.lane; asm volatile("" : "+v"(lane)); const int h = F.wave, r = lane & 31, hh = lane >> 5;
    const bool sample = cu >= 512; const size_t row0 = sample ? (size_t)MP + (size_t)(cu - 512) * 32 : (size_t)cu * 64; const int nvalid = sample ? 32 : 64;
    const size_t ch = (size_t)cu * 8 + h;
    LAS float* Mf = (LAS float*)(F.lds + h * 18432); LAS float* tabG = Mf + 4096; LAS float* tabB = tabG + 64;
    float gc = lane < nvalid ? GARR[(row0 + lane) * 8 + h] : 0.f; const float be = lane < nvalid ? BETA[(row0 + lane) * 8 + h] : 0.f;
#pragma unroll
    for (int o = 1; o < 64; o <<= 1) { const float t = __shfl_up(gc, o); if (lane >= o) gc += t; }
    const float glast = __shfl(gc, 63);
    tabG[lane] = gc; tabB[lane] = be;
    DEG[ch * 128 + lane] = __expf(gc); DEG[ch * 128 + 64 + lane] = __expf(glast - gc);
    bf16x8 kf[2][8];
#pragma unroll
    for (int ib = 0; ib < 2; ++ib)
#pragma unroll
        for (int d0 = 0; d0 < 8; ++d0) { if (sample && ib == 1) kf[ib][d0] = (bf16x8){0, 0, 0, 0, 0, 0, 0, 0}; else kf[ib][d0] = *(const bf16x8*)(QKVC + (row0 + 32 * ib + r) * CONVCH + 1024 + h * 128 + 16 * d0 + 8 * hh); }
    const float gj0 = __shfl(gc, r), gj1 = __shfl(gc, 32 + r);
    LDS_WAIT();
#pragma unroll
    for (int t3 = 0; t3 < 3; ++t3) { const int ib = t3 == 0 ? 0 : 1, jb = t3 == 2 ? 1 : 0;
        f32x16 acc;
#pragma unroll
        for (int i = 0; i < 16; ++i) acc[i] = 0.f;
#pragma unroll
        for (int d0 = 0; d0 < 8; ++d0) acc = __builtin_amdgcn_mfma_f32_32x32x16_bf16(kf[ib][d0], kf[jb][d0], acc, 0, 0, 0);
        const float gj = jb ? gj1 : gj0;
#pragma unroll
        for (int q = 0; q < 16; ++q) { const int i = 32 * ib + (q & 3) + 8 * (q >> 2) + 4 * hh; const float d = fminf(tabG[i] - gj, 0.f);
            Mf[i * 64 + 32 * jb + r] = tabB[i] * acc[q] * __expf(d); }
    }
    {
        bf16x8 qf[2][8];
#pragma unroll
        for (int ib = 0; ib < 2; ++ib)
#pragma unroll
            for (int d0 = 0; d0 < 8; ++d0) { if (sample && ib == 1) qf[ib][d0] = (bf16x8){0, 0, 0, 0, 0, 0, 0, 0}; else qf[ib][d0] = *(const bf16x8*)(QKVC + (row0 + 32 * ib + r) * CONVCH + h * 128 + 16 * d0 + 8 * hh); }
#pragma unroll
        for (int t3 = 0; t3 < 3; ++t3) { const int ib = t3 == 0 ? 0 : 1, jb = t3 == 2 ? 1 : 0;
            f32x16 acc;
#pragma unroll
            for (int i = 0; i < 16; ++i) acc[i] = 0.f;
#pragma unroll
            for (int d0 = 0; d0 < 8; ++d0) acc = __builtin_amdgcn_mfma_f32_32x32x16_bf16(qf[ib][d0], kf[jb][d0], acc, 0, 0, 0);
            const float gj = jb ? gj1 : gj0; const int j = 32 * jb + r;
#pragma unroll
            for (int q = 0; q < 16; ++q) { const int i = 32 * ib + (q & 3) + 8 * (q >> 2) + 4 * hh; const float d = fminf(tabG[i] - gj, 0.f);
                const float a = i >= j ? acc[q] * __expf(d) : 0.f;
                DAL[ch * 4096 + i * 64 + j] = (bf16)(pk2(a, 0.f) & 0xffffu); }
        }
    }
    LDS_WAIT();
#pragma unroll 1
    for (int p = 0; p < 4; ++p) {
        const bool isw = p >= 2; const int col = 64 * (p & 1) + lane;
        unsigned mbase = (unsigned)(uintptr_t)Mf; asm volatile("" : "+v"(mbase)); LAS float* Mp = (LAS float*)(uintptr_t)mbase;
        const bf16* src = QKVC + row0 * CONVCH + (isw ? 1024 : 2048) + h * 128 + col;
        Mp[4096 + 128 + lane] = isw ? be * __expf(gc) : be;
        float x[64];
#pragma unroll
        for (int i = 0; i < 64; ++i) { const int ic = (sample && i >= 32) ? 31 : i; x[i] = bf1(src[(size_t)ic * CONVCH]); }
        asm volatile("s_waitcnt vmcnt(0) lgkmcnt(0)" ::: "memory");
        __builtin_amdgcn_sched_barrier(0);
#pragma unroll
        for (int i = 0; i < 64; ++i) {
            const float b = Mp[4096 + 128 + i] * x[i];
            float a0 = 0.f, a1 = 0.f, a2 = 0.f, a3 = 0.f;
            const LAS f32x4* Mrow = (const LAS f32x4*)(Mp + i * 64);
#pragma unroll
            for (int j4 = 0; j4 < (i + 3) / 4; ++j4) { const f32x4 m = Mrow[j4];
                if (4 * j4 + 0 < i) a0 += m.x * x[4 * j4 + 0];
                if (4 * j4 + 1 < i) a1 += m.y * x[4 * j4 + 1];
                if (4 * j4 + 2 < i) a2 += m.z * x[4 * j4 + 2];
                if (4 * j4 + 3 < i) a3 += m.w * x[4 * j4 + 3]; }
            x[i] = b - ((a0 + a1) + (a2 + a3));
            __builtin_amdgcn_sched_barrier(0);
        }
        if (!isw) { bf16* dst = dut_ptr(F.ws, ch) + (size_t)col * 64;
#pragma unroll
            for (int i8 = 0; i8 < 8; ++i8) { u32x4 o; o.x = pk2(x[8 * i8], x[8 * i8 + 1]); o.y = pk2(x[8 * i8 + 2], x[8 * i8 + 3]); o.z = pk2(x[8 * i8 + 4], x[8 * i8 + 5]); o.w = pk2(x[8 * i8 + 6], x[8 * i8 + 7]); *(u32x4*)(dst + 8 * i8) = o; } }
        else { bf16* dst = DW + ch * 8192 + col;
#pragma unroll
            for (int i = 0; i < 64; ++i) dst[i * 128] = (bf16)(pk2(x[i], 0.f) & 0xffffu); }
    }
}

__device__ __forceinline__ int vt_off(int e, int chunk) { return 128 * e + 16 * (chunk ^ ((e >> 1) & 7)); }
__device__ __forceinline__ void delta_scan_unit(const Frame& F, int seq, int h) {
    const bf16* DW = (const bf16*)(F.ws + WS_DW); const bf16* DAL = (const bf16*)(F.ws + WS_DAL); const float* DEG = (const float*)(F.ws + WS_DEG);
    const bf16* QKVC = (const bf16*)(F.ws + WS_QKVC); const bf16* DG = (const bf16*)(F.ws + WS_DG); bf16* OB = (bf16*)(F.ws + WS_OAB) + (size_t)MT * DM; const float* dnw = F.in[19];
    int tid = F.tid; asm volatile("" : "+v"(tid)); const int lane = tid & 63, w = F.wave, r = lane & 31, hh = lane >> 5;
    const bool sample = seq >= NB; const int nsteps = sample ? 1 : 32; const int nvalid = sample ? 32 : 64;
    const size_t rowbase = sample ? (size_t)MP + (size_t)(seq - NB) * DSEQ : (size_t)seq * SEQ;
    const size_t ch0 = sample ? (size_t)(512 + (seq - NB)) * 8 + h : (size_t)(seq * 32) * 8 + h;
    float* sout = F.out + (sample ? OFF_DS + ((size_t)(seq - NB) * NH + h) * 16384 : OFF_DP + ((size_t)seq * NH + h) * 16384);
    LAS unsigned char* ST = F.lds; LAS unsigned char* VT = F.lds + 32768; LAS unsigned char* VTP = F.lds + 49152; LAS unsigned char* KI = F.lds + 65536;
    LAS float* Ost = (LAS float*)(F.lds + 98304); LAS float* tab0 = (LAS float*)(F.lds + 131072);
    const int ib = w & 1, ebp = w >> 1, dkb = w >> 1, eb0 = 2 * (w & 1);
    f32x16 S[2];
    if (sample) { const float* s0 = F.in[4] + ((size_t)(seq - NB) * NH + h) * 16384;
#pragma unroll
        for (int t = 0; t < 2; ++t)
#pragma unroll
            for (int q = 0; q < 16; ++q) S[t][q] = s0[(size_t)(32 * dkb + (q & 3) + 8 * (q >> 2) + 4 * hh) * 128 + 32 * (eb0 + t) + r]; }
    else {
#pragma unroll
        for (int t = 0; t < 2; ++t)
#pragma unroll
            for (int q = 0; q < 16; ++q) S[t][q] = 0.f; }
    __syncthreads();
#define WRITE_ST() do { _Pragma("unroll") for (int t_ = 0; t_ < 2; ++t_) { const int e_ = 32 * (eb0 + t_) + r; _Pragma("unroll") for (int g4 = 0; g4 < 4; ++g4) { \
        u32x2 o_; o_.x = pk2(S[t_][4 * g4], S[t_][4 * g4 + 1]); o_.y = pk2(S[t_][4 * g4 + 2], S[t_][4 * g4 + 3]); \
        *(LAS u32x2*)(ST + tile_off(e_, 4 * dkb + g4) + 8 * hh) = o_; } } } while (0)
    WRITE_ST();
    const int pr0 = tid >> 4, pc = tid & 15; const int so0 = tile_off(pr0, pc), so1 = tile_off(pr0 + 32, pc);
    const bf16* kbase = QKVC + (rowbase + pr0) * CONVCH + 1024 + h * 128 + pc * 8;
    u32x4 kst[2];
    kst[0] = *(const u32x4*)kbase; kst[1] = (sample) ? (u32x4){0u, 0u, 0u, 0u} : *(const u32x4*)(kbase + (size_t)32 * CONVCH);
    *(LAS u32x4*)(KI + so0) = kst[0]; *(LAS u32x4*)(KI + so1) = kst[1];
    int vb[1][2];
    { const int gsel = (lane >> 4) & 1, q = (lane >> 2) & 3, p = lane & 3;
#pragma unroll
      for (int hl = 0; hl < 2; ++hl) { const int row = 4 * hh + q + 8 * hl; vb[0][hl] = 256 * row + 16 * ((4 * dkb + 2 * gsel + (p >> 1)) ^ swz_f(row)) + 8 * (p & 1); } }
    const int e1 = 32 * ebp + r;
    const int st_row = 256 * e1, st_fz = swz_f(e1) ^ hh;
    for (int n = 0; n < nsteps; ++n) {
        const size_t ch = ch0 + 8 * (size_t)n; const size_t rown = rowbase + (size_t)n * 64;
        bf16x8 wf[8], qf[8];
        { const bool zr = sample && ib == 1;
#pragma unroll
          for (int d0 = 0; d0 < 8; ++d0) { wf[d0] = *(const bf16x8*)(DW + ch * 8192 + (size_t)(32 * ib + r) * 128 + 16 * d0 + 8 * hh);
              qf[d0] = zr ? (bf16x8){0, 0, 0, 0, 0, 0, 0, 0} : *(const bf16x8*)(QKVC + (rown + 32 * ib + r) * CONVCH + h * 128 + 16 * d0 + 8 * hh); } }
        LAS float* tabEG = tab0 + (n & 1) * 128; LAS float* tabET = tabEG + 64;
        if (tid < 128) tabEG[tid] = DEG[ch * 128 + tid];
        const bool more = n + 1 < nsteps;
        if (more) { const bf16* kn = kbase + (size_t)(n + 1) * 64 * CONVCH; kst[0] = *(const u32x4*)kn; kst[1] = *(const u32x4*)(kn + (size_t)32 * CONVCH); }
        __syncthreads();
        if (n > 0) {
            const size_t rowp = rown - 64;
#pragma unroll
            for (int ff = 0; ff < 8; ++ff) { const int f = 8 * w + ff; const float a = Ost[f * 128 + 2 * lane], c = Ost[f * 128 + 2 * lane + 1];
                const float ss = wave_sum(a * a + c * c); const float rs = rsqrtf(ss * (1.f / 128.f) + EPS);
                const unsigned gw_ = *(const unsigned*)(DG + (rowp + f) * DM + h * 128 + 2 * lane); const float g0 = bflo(gw_), g1 = bfhi(gw_);
                *(unsigned*)(OB + (rowp + f) * DM + h * 128 + 2 * lane) = pk2(a * rs * dnw[2 * lane] * (g0 * sigmoidf_(g0)), c * rs * dnw[2 * lane + 1] * (g1 * sigmoidf_(g1))); }
        }
        f32x16 ws_, qs_;
#pragma unroll
        for (int q = 0; q < 16; ++q) { ws_[q] = 0.f; qs_[q] = 0.f; }
#pragma unroll
        for (int d0 = 0; d0 < 8; ++d0) { const bf16x8 sf = *(const LAS bf16x8*)(ST + st_row + 16 * ((2 * d0) ^ st_fz));
            ws_ = __builtin_amdgcn_mfma_f32_32x32x16_bf16(wf[d0], sf, ws_, 0, 0, 0); qs_ = __builtin_amdgcn_mfma_f32_32x32x16_bf16(qf[d0], sf, qs_, 0, 0, 0); }
        { const bf16* up = dut_ptr(F.ws, ch) + (size_t)e1 * 64 + 32 * ib + 4 * hh;
#pragma unroll
          for (int g4 = 0; g4 < 4; ++g4) { const u32x2 uu = *(const u32x2*)(up + 8 * g4); const int i0 = 32 * ib + 8 * g4 + 4 * hh;
              const float v0 = bflo(uu.x) - ws_[4 * g4], v1 = bfhi(uu.x) - ws_[4 * g4 + 1], v2 = bflo(uu.y) - ws_[4 * g4 + 2], v3 = bfhi(uu.y) - ws_[4 * g4 + 3];
              const f32x4 et = *(const LAS f32x4*)(tabET + i0), eg = *(const LAS f32x4*)(tabEG + i0);
              u32x2 a, b; a.x = pk2(v0, v1); a.y = pk2(v2, v3); b.x = pk2(v0 * et.x, v1 * et.y); b.y = pk2(v2 * et.z, v3 * et.w);
              const int off = vt_off(e1, 4 * ib + g4) + 8 * hh;
              *(LAS u32x2*)(VT + off) = a; *(LAS u32x2*)(VTP + off) = b;
              qs_[4 * g4] *= eg.x; qs_[4 * g4 + 1] *= eg.y; qs_[4 * g4 + 2] *= eg.z; qs_[4 * g4 + 3] *= eg.w; } }
        if (more) { LAS unsigned char* KN = KI + ((n + 1) & 1) * 16384; *(LAS u32x4*)(KN + so0) = kst[0]; *(LAS u32x4*)(KN + so1) = kst[1]; }
        __syncthreads();
#pragma unroll
        for (int jb = 0; jb < 2; ++jb) { if (jb <= ib) {
#pragma unroll
            for (int s = 0; s < 2; ++s) { const bf16x8 af = *(const bf16x8*)(DAL + ch * 4096 + (size_t)(32 * ib + r) * 64 + 32 * jb + 16 * s + 8 * hh);
                const bf16x8 vf = *(const LAS bf16x8*)(VT + vt_off(e1, 4 * jb + 2 * s + hh));
                qs_ = __builtin_amdgcn_mfma_f32_32x32x16_bf16(af, vf, qs_, 0, 0, 0); } } }
#pragma unroll
        for (int q = 0; q < 16; ++q) Ost[(32 * ib + (q & 3) + 8 * (q >> 2) + 4 * hh) * 128 + e1] = qs_[q];
        { const float gt = tabEG[63]; const LAS unsigned char* KC = KI + (n & 1) * 16384;
#pragma unroll
          for (int t = 0; t < 2; ++t) { const int e = 32 * (eb0 + t) + r;
#pragma unroll
              for (int q = 0; q < 16; ++q) S[t][q] *= gt;
#pragma unroll
              for (int kb = 0; kb < 2; ++kb)
#pragma unroll
                  for (int s = 0; s < 2; ++s) {
                      const s16x4 lo = vtr(KC + vb[0][0] + 8192 * kb + 4096 * s), hi = vtr(KC + vb[0][1] + 8192 * kb + 4096 * s);
                      const u32x2 b0 = *(const LAS u32x2*)(VTP + vt_off(e, 4 * kb + 2 * s) + 8 * hh), b1 = *(const LAS u32x2*)(VTP + vt_off(e, 4 * kb + 2 * s + 1) + 8 * hh);
                      const u32x4 bb = {b0.x, b0.y, b1.x, b1.y};
                      S[t] = __builtin_amdgcn_mfma_f32_32x32x16_bf16((bf16x8){lo[0], lo[1], lo[2], lo[3], hi[0], hi[1], hi[2], hi[3]}, __builtin_bit_cast(bf16x8, bb), S[t], 0, 0, 0); } } }
        WRITE_ST();
    }
#undef WRITE_ST
    __syncthreads();
    { const size_t rowp = rowbase + (size_t)(nsteps - 1) * 64;
#pragma unroll
      for (int ff = 0; ff < 8; ++ff) { const int f = 8 * w + ff; if (f < nvalid) { const float a = Ost[f * 128 + 2 * lane], c = Ost[f * 128 + 2 * lane + 1];
          const float ss = wave_sum(a * a + c * c); const float rs = rsqrtf(ss * (1.f / 128.f) + EPS);
          const unsigned gw_ = *(const unsigned*)(DG + (rowp + f) * DM + h * 128 + 2 * lane); const float g0 = bflo(gw_), g1 = bfhi(gw_);
          *(unsigned*)(OB + (rowp + f) * DM + h * 128 + 2 * lane) = pk2(a * rs * dnw[2 * lane] * (g0 * sigmoidf_(g0)), c * rs * dnw[2 * lane + 1] * (g1 * sigmoidf_(g1))); } } }
#pragma unroll
    for (int t = 0; t < 2; ++t)
#pragma unroll
        for (int q = 0; q < 16; ++q) sout[(size_t)(32 * dkb + (q & 3) + 8 * (q >> 2) + 4 * hh) * 128 + 32 * (eb0 + t) + r] = S[t][q];
}
#define LAS_ LAS
#define XB_TMO      128
#define XB_XCNT(j)  (256  + 64 * (j))
#define XB_XSUB(j)  (1280 + 64 * (j))
#define XB_XGEN(j)  (2304 + 64 * (j))
#define XB_TOP      3328
#define XB_TOPGEN   3392
#define XCD_BAR_WORDS 3456
#define XB_SPIN_CAP (1u << 18)

__device__ __forceinline__ unsigned xb_ld(unsigned* p)              { return __hip_atomic_load(p, __ATOMIC_RELAXED, __HIP_MEMORY_SCOPE_AGENT); }
__device__ __forceinline__ unsigned xb_add(unsigned* p, unsigned v) { return __hip_atomic_fetch_add(p, v, __ATOMIC_RELAXED, __HIP_MEMORY_SCOPE_AGENT); }
__device__ __forceinline__ unsigned xb_xcc_id() { return (unsigned)__builtin_amdgcn_s_getreg((3 << 11) | 20) & 0xFu; }
#define XB_SPIN(cond, bar) do { unsigned _sp = 0; while (cond) { __builtin_amdgcn_s_sleep(1); \
    if ((++_sp & 255u) == 0u) { if (xb_ld(&(bar)[XB_TMO])) break; if (_sp > XB_SPIN_CAP) { atomicAdd(&(bar)[XB_TMO], 1u); break; } } } } while (0)

struct XcdBarrier {
    unsigned* bar; unsigned x;
    volatile LAS unsigned* st;
};

__device__ __forceinline__ XcdBarrier xcd_barrier_post(unsigned* bar, volatile LAS unsigned* st) {
    XcdBarrier b; b.bar = bar; b.x = xb_xcc_id(); b.st = st;
    if (threadIdx.x == 0) (void)xb_add(&bar[XB_XCNT(b.x)], 1u);
    return b;
}
__device__ __forceinline__ void xcd_barrier_complete(unsigned* bar, unsigned x, unsigned& nloc, unsigned& nx) {
    const unsigned G = gridDim.x * gridDim.y * gridDim.z;
    unsigned sum, cnt, mine, sp = 0u;
    for (;;) {
        sum = 0u; cnt = 0u; mine = 0u;
#pragma unroll
        for (unsigned j = 0; j < 16; ++j) { const unsigned c = xb_ld(&bar[XB_XCNT(j)]); sum += c; cnt += (c > 0u) ? 1u : 0u; mine = (j == x) ? c : mine; }
        if (sum == G) break;
        __builtin_amdgcn_s_sleep(1);
        if ((++sp & 255u) == 0u) { if (xb_ld(&bar[XB_TMO])) break; if (sp > XB_SPIN_CAP) { atomicAdd(&bar[XB_TMO], 1u); break; } }
    }
    nloc = mine > 0u ? mine : 1u; nx = cnt > 0u ? cnt : 1u;
}

__device__ __forceinline__ void xcd_barrier(const XcdBarrier& b) {
    asm volatile("s_waitcnt vmcnt(0)" ::: "memory");
    __syncthreads();
    if (threadIdx.x == 0) {
        unsigned* bar = b.bar;
        __builtin_amdgcn_s_waitcnt(0);
        unsigned nloc = b.st[0], nx = b.st[1];
        if (nloc == 0u) { xcd_barrier_complete(bar, b.x, nloc, nx); b.st[0] = nloc; b.st[1] = nx; }
        const unsigned old = xb_add(&bar[XB_XSUB(b.x)], 1u);
        const unsigned gen = old / nloc;
        if (old + 1u == (gen + 1u) * nloc) {
            __builtin_amdgcn_fence(__ATOMIC_RELEASE, "agent");
            asm volatile("s_waitcnt vmcnt(0)" ::: "memory");
            const unsigned og = xb_add(&bar[XB_TOP], 1u);
            const unsigned tg = og / nx;
            if (og + 1u == (tg + 1u) * nx) xb_add(&bar[XB_TOPGEN], 1u);
            else XB_SPIN(xb_ld(&bar[XB_TOPGEN]) == tg, bar);
            __builtin_amdgcn_fence(__ATOMIC_ACQUIRE, "agent");
            xb_add(&bar[XB_XGEN(b.x)], 1u);
            asm volatile("s_waitcnt vmcnt(0)" ::: "memory");
        } else {
            XB_SPIN(xb_ld(&bar[XB_XGEN(b.x)]) == gen, bar);
            __builtin_amdgcn_fence(__ATOMIC_ACQUIRE, "agent");
            asm volatile("s_waitcnt vmcnt(0)" ::: "memory");
        }
    }
    __syncthreads();
}

#ifndef PROBE_DUP
#define PROBE_DUP -1
#endif
#ifndef USE_XCDBAR
#define USE_XCDBAR 1
#endif
constexpr int CW_BAR = 1024, CW_Q4 = 192;
constexpr int N_PHASES = 9;
__device__ __forceinline__ int next_unit(const Frame& F, unsigned* ctr) {
    volatile LAS int* slot = (volatile LAS int*)(F.lds + LDS_BYTES - 16);
    __syncthreads();
    if (F.tid == 0) *slot = (int)__hip_atomic_fetch_add(ctr, 1u, __ATOMIC_RELAXED, __HIP_MEMORY_SCOPE_AGENT);
    __syncthreads();
    return *slot;
}

template <int PH> __device__ __forceinline__ void run_phase(const Frame& F, int rep = 0) {
    unsigned char* ws = F.ws;
    if constexpr (PH == 0) { p0_prologue(F); }
    if constexpr (PH == 1) {
        pg8::Gemm g{(const bf16*)(ws + WS_XN), (const bf16*)(ws + WS_WIN), MT, NZ, DM}; pg8::StaticOrder S; S.init(MT, NZ, F.G, F.bid);
        pg8::EpiZ E{ws, F.out};
        pg8::gemm_phase<pg8::EpiZ, pg8::StaticOrder, true, true>(F.lds, g, S, E);
    }
    if constexpr (PH == 2) {
        unsigned* ctr = (unsigned*)(ws + WS_CTL) + CW_Q2 + 16 * rep;
        for (;;) { const int u = next_unit(F, ctr); if (u >= 256 + 780) break;
            if (u < 256) attn_sample_unit(F, u >> 4, (u >> 1) & 7, u & 1);
            else conv_task(F, (u - 256) * 8 + F.wave); }
    }
    if constexpr (PH == 3) {
        unsigned* ctr = (unsigned*)(ws + WS_CTL) + CW_Q3 + 16 * rep;
        for (;;) { const int u = next_unit(F, ctr); if (u >= NCH) break; delta_chunk_unit(F, u); }
    }
    if constexpr (PH == 8) {
        unsigned* ctr = (unsigned*)(ws + WS_CTL) + CW_Q4 + 16 * rep;
        const float lam = lambda_of(F);
        for (;;) { const int u = next_unit(F, ctr); if (u >= 128 + 2048 + 128 + 128) break;
            if (u < 128) delta_scan_unit(F, u >> 3, u & 7);
            else if (u < 2176) { const int a = u - 128; attn_prompt_unit(F, a & 15, (a >> 4) & 7, 15 - (a >> 7), lam); }
            else if (u < 2304) { const int a = u - 2176; delta_scan_unit(F, NB + (a >> 3), a & 7); }
            else { const int a = u - 2304; attn_sample_combine(F, a >> 3, a & 7, lam); } }
    }
    if constexpr (PH == 4) {
        pg8::Gemm g{(const bf16*)(ws + WS_OAB), (const bf16*)(ws + WS_WAB), 2 * MT, 2048, DM}; pg8::PairOrder S{F.G, F.bid};
        pg8::EpiAB E{ws, F.out + OFF_Y};
        pg8::gemm_phase<pg8::EpiAB, pg8::PairOrder, true, true>(F.lds, g, S, E);
    }
    if constexpr (PH == 5) {
        pg8::Gemm g{(const bf16*)(ws + WS_MERGED), (const bf16*)(ws + WS_WO), MT, DM, DM}; pg8::StaticOrder S; S.init(MT, DM, F.G, F.bid);
        pg8::EpiOut E{F.in[0], F.in[1], F.out + OFF_Y, (bf16*)(ws + WS_X1B), (float*)(ws + WS_RSS)};
        pg8::gemm_phase<pg8::EpiOut, pg8::StaticOrder, true, true>(F.lds, g, S, E);
    }
    if constexpr (PH == 6) {
        pg8::Gemm g{(const bf16*)(ws + WS_X1B), (const bf16*)(ws + WS_WGU), MT, 2 * DFF, DM}; pg8::StaticOrder S; S.init(MT, 2 * DFF, F.G, F.bid);
        pg8::EpiGU E{(const float*)(ws + WS_RSS), (bf16*)(ws + WS_ACT)};
        pg8::gemm_phase<pg8::EpiGU, pg8::StaticOrder, true, true>(F.lds, g, S, E);
    }
    if constexpr (PH == 7) {
        pg8::Gemm g{(const bf16*)(ws + WS_ACT), (const bf16*)(ws + WS_WD), MT, DM, DFF}; pg8::StaticOrder S; S.init(MT, DM, F.G, F.bid);
        pg8::EpiDown E{F.out + OFF_Y};
        pg8::gemm_phase<pg8::EpiDown, pg8::StaticOrder, true, true>(F.lds, g, S, E);
    }
}

__device__ __forceinline__ Frame make_frame(const Args& a, unsigned char* lds) {
    Frame F; F.lds = (LAS unsigned char*)lds; F.ws = a.ws; F.out = a.out; F.in = a.in;
    F.tid = threadIdx.x; F.lane = F.tid & 63; F.wave = __builtin_amdgcn_readfirstlane(F.tid >> 6); F.G = gridDim.x; F.bid = blockIdx.x;
    return F;
}

#if MEGA
__global__ void __launch_bounds__(NTHREADS, 2) mega_kernel(Args a) {
    extern __shared__ __attribute__((aligned(16))) unsigned char lds[];
    cg::grid_group grid = cg::this_grid();
    const Frame F = make_frame(a, lds);
#if USE_XCDBAR
    if (F.tid < 8) ((LAS unsigned*)(F.lds + LDS_BYTES - 64))[F.tid] = 0u;
    __syncthreads();
    XcdBarrier bar = xcd_barrier_post((unsigned*)(a.ws + WS_CTL) + CW_BAR, (volatile LAS unsigned*)(F.lds + LDS_BYTES - 64));
#define SEAM() xcd_barrier(bar)
#else
#define SEAM() grid.sync()
#endif
#define PHASE(k) do { run_phase<k>(F); if (PROBE_DUP == k) { SEAM(); run_phase<k>(F, 1); } } while (0)
    PHASE(0); grid.sync();
    PHASE(1); SEAM();
    PHASE(2); SEAM();
    PHASE(3); SEAM();
    PHASE(8); SEAM();
    PHASE(4); SEAM();
    PHASE(5); SEAM();
    PHASE(6); SEAM();
    run_phase<7>(F);
#undef PHASE
#undef SEAM
}
#else
template <int PH> __global__ void __launch_bounds__(NTHREADS, 2) phase_kernel(Args a) {
    extern __shared__ __attribute__((aligned(16))) unsigned char lds[];
    const Frame F = make_frame(a, lds);
    run_phase<PH>(F);
}
#endif

extern "C" void kernel_launch(void* const* d_in, const int* in_sizes, int n_in, void* d_out, int out_size, void* d_ws, size_t ws_size, hipStream_t stream) {
    static int grid = 0;
    if (grid == 0) {
        if (n_in != 25 || out_size != (int)OUT_TOTAL || ws_size < WS_END2) { fprintf(stderr, "kernel_launch: unexpected shapes n_in %d out %d ws %zu\n", n_in, out_size, ws_size); grid = -1; return; }
        int dev = 0, cus = 0;
        hipGetDevice(&dev); hipDeviceGetAttribute(&cus, hipDeviceAttributeMultiprocessorCount, dev);
#if MEGA
        hipFuncSetAttribute((const void*)mega_kernel, hipFuncAttributeMaxDynamicSharedMemorySize, LDS_BYTES);
        int per_cu = 0; hipOccupancyMaxActiveBlocksPerMultiprocessor(&per_cu, (const void*)mega_kernel, NTHREADS, LDS_BYTES);
        if (per_cu < 1) { fprintf(stderr, "kernel_launch: occupancy query says %d blocks per CU\n", per_cu); per_cu = 1; }
#else
        hipFuncSetAttribute((const void*)phase_kernel<0>, hipFuncAttributeMaxDynamicSharedMemorySize, LDS_BYTES);
        hipFuncSetAttribute((const void*)phase_kernel<1>, hipFuncAttributeMaxDynamicSharedMemorySize, LDS_BYTES);
        hipFuncSetAttribute((const void*)phase_kernel<2>, hipFuncAttributeMaxDynamicSharedMemorySize, LDS_BYTES);
        hipFuncSetAttribute((const void*)phase_kernel<3>, hipFuncAttributeMaxDynamicSharedMemorySize, LDS_BYTES);
        hipFuncSetAttribute((const void*)phase_kernel<4>, hipFuncAttributeMaxDynamicSharedMemorySize, LDS_BYTES);
        hipFuncSetAttribute((const void*)phase_kernel<5>, hipFuncAttributeMaxDynamicSharedMemorySize, LDS_BYTES);
        hipFuncSetAttribute((const void*)phase_kernel<6>, hipFuncAttributeMaxDynamicSharedMemorySize, LDS_BYTES);
        hipFuncSetAttribute((const void*)phase_kernel<7>, hipFuncAttributeMaxDynamicSharedMemorySize, LDS_BYTES);
#endif
        (void)hipGetLastError();
        grid = cus > 0 ? cus : 256;
    }
    if (grid < 0) return;
    hipMemsetAsync((char*)d_ws + WS_CTL, 0, CTL_ZERO_BYTES, stream);
    Args a{};
    for (int i = 0; i < 25; ++i) a.in[i] = (const float*)d_in[i];
    a.out = (float*)d_out; a.ws = (unsigned char*)d_ws; a.ph_lo = 0; a.ph_hi = N_PHASES;
#if MEGA
    void* args[] = {&a};
    hipError_t e = hipLaunchCooperativeKernel((const void*)mega_kernel, dim3(grid), dim3(NTHREADS), args, LDS_BYTES, stream);
    if (e != hipSuccess) fprintf(stderr, "cooperative launch failed: %s (grid %d)\n", hipGetErrorString(e), grid);
#else
    hipLaunchKernelGGL(phase_kernel<0>, dim3(grid), dim3(NTHREADS), LDS_BYTES, stream, a);
    hipLaunchKernelGGL(phase_kernel<1>, dim3(grid), dim3(NTHREADS), LDS_BYTES, stream, a);
    hipLaunchKernelGGL(phase_kernel<2>, dim3(grid), dim3(NTHREADS), LDS_BYTES, stream, a);
    hipLaunchKernelGGL(phase_kernel<3>, dim3(grid), dim3(NTHREADS), LDS_BYTES, stream, a);
    hipLaunchKernelGGL(phase_kernel<4>, dim3(grid), dim3(NTHREADS), LDS_BYTES, stream, a);
    hipLaunchKernelGGL(phase_kernel<5>, dim3(grid), dim3(NTHREADS), LDS_BYTES, stream, a);
    hipLaunchKernelGGL(phase_kernel<6>, dim3(grid), dim3(NTHREADS), LDS_BYTES, stream, a);
    hipLaunchKernelGGL(phase_kernel<7>, dim3(grid), dim3(NTHREADS), LDS_BYTES, stream, a);
#endif
}
```

```cpp
#include <hip/hip_runtime.h>
#include <hip/hip_cooperative_groups.h>
#include <cstdio>
#include <cstdint>
namespace cg = cooperative_groups;

#define LAS __attribute__((address_space(3)))
#define GAS __attribute__((address_space(1)))
typedef float f32x2 __attribute__((ext_vector_type(2)));
typedef float f32x16 __attribute__((ext_vector_type(16)));
typedef unsigned u32x2 __attribute__((ext_vector_type(2)));
typedef short s16x4 __attribute__((ext_vector_type(4)));
typedef __bf16 bf16x2_t __attribute__((ext_vector_type(2)));

constexpr int DM = 1024, NB = 16, SEQ = 2048, DECB = 16, DSEQ = 32, PAST = 4096;
constexpr int MP = NB * SEQ, MS = DECB * DSEQ, MT = MP + MS;
constexpr int NH = 8, DIN = 9232, NZ = 9216, DFF = 2816, CONVCH = 3072;
constexpr float EPS = 1e-6f;
constexpr float LAM_INIT = 0.2f;
constexpr float QSCALE = 0.125f * 1.4426950408889634f;
constexpr size_t OFF_Y = 0;
constexpr size_t OFF_KP = (size_t)MT * DM;
constexpr size_t OFF_VP = OFF_KP + (size_t)MP * DM;
constexpr size_t OFF_DP = OFF_VP + (size_t)MP * DM;
constexpr size_t OFF_CP = OFF_DP + (size_t)NB * NH * 128 * 128;
constexpr size_t OFF_KS = OFF_CP + (size_t)NB * 3 * CONVCH;
constexpr size_t OFF_VS = OFF_KS + (size_t)MS * DM;
constexpr size_t OFF_DS = OFF_VS + (size_t)MS * DM;
constexpr size_t OFF_CS = OFF_DS + (size_t)DECB * NH * 128 * 128;
constexpr size_t OUT_TOTAL = OFF_CS + (size_t)DECB * 3 * CONVCH;
static_assert(OUT_TOTAL == 106725376ull, "output size");

__device__ __forceinline__ int fresh_lane_id() { unsigned z = 0u; asm volatile("" : "+s"(z)); return (int)__builtin_amdgcn_mbcnt_hi(~0u, __builtin_amdgcn_mbcnt_lo(~0u, z)); }
#define MEGA 1

namespace pg8 {
#define PG8_LAS __attribute__((address_space(3)))
typedef unsigned short bf16_t;
typedef short bf16x8 __attribute__((ext_vector_type(8)));
typedef float f32x4 __attribute__((ext_vector_type(4)));
typedef unsigned u32x4 __attribute__((ext_vector_type(4)));
constexpr int BM = 256, BK = 64, HALF = 128, HTB = HALF * BK * 2  , STAGE_BYTES = 8 * HTB, NXCD = 8, WGM = 8;

__host__ __device__ __forceinline__ int lds_byte(int r, int c) { const int st = (r >> 4) * 2 + (c >> 5), rr = r & 15, cc = c & 31, ob = rr * 64 + cc * 2; return st * 1024 + (ob ^ (((ob >> 9) & 1) << 5)); }
__host__ __device__ __forceinline__ void stage_rc(int b, int& R, int& C) { const int st = b / 1024, sb = b % 1024, swz = sb ^ (((sb >> 9) & 1) << 5); R = (st >> 1) * 16 + swz / 64; C = (st & 1) * 32 + (swz % 64) / 2; }
__host__ __device__ __forceinline__ int perm32(int rho) { const int n = rho >> 4, i = rho & 15; return 8 * (i >> 2) + 4 * n + (i & 3); }

struct Unit { int pm, pn; };
struct Gemm { const bf16_t* A; const bf16_t* Bt; int M, N, K; };

struct StaticOrder {
    int nM, nN, nwg, G, c;
    __host__ __device__ void init(int M, int N, int G_, int c_) { nM = M / BM; nN = N / BM; nwg = nM * nN; G = G_; c = c_; }
    __host__ __device__ bool next(int i, Unit& u) const {
        const long L = (long)i * G + c; if (L >= nwg) return false;
        int wgid = (int)L; { const int q = nwg / NXCD, r = nwg % NXCD, xcd = wgid % NXCD, off = wgid / NXCD; wgid = (xcd < r ? xcd * (q + 1) : r * (q + 1) + (xcd - r) * q) + off; }
        const int nig = WGM * nN, gid = wgid / nig, fm = gid * WGM, gsz = (nM - fm) < WGM ? (nM - fm) : WGM;
        u.pm = fm + ((wgid % nig) % gsz); u.pn = (wgid % nig) / gsz; return true;
    }
    __device__ __forceinline__ void a_ready(const Unit&) const {}
    __device__ __forceinline__ void done(const Unit&) const {}
};

template <class Epi, class Sched, bool ALIGN_EPI = false, bool SP2 = false>
__device__ __forceinline__ void gemm_phase(PG8_LAS unsigned char* lds, const Gemm g, const Sched& S, const Epi& E, int wid_in) {
    int tid_ = wid_in * 64 + fresh_lane_id(); asm volatile("" : "+v"(tid_));
    const int tid = tid_, wid = __builtin_amdgcn_readfirstlane(tid >> 6), lane = tid & 63, wr = wid >> 2, wc = wid & 3, fr = lane & 15, fq = lane >> 4;
    const int K = g.K, nt = K / BK;
    unsigned voffA[2], voffB[2];
#pragma unroll
    for (int i = 0; i < 2; ++i) { int R, C; stage_rc(tid * 16 + i * 8192, R, C); const int Rb = Epi::PERM ? ((R & ~31) + perm32(R & 31)) : R;
        voffA[i] = (unsigned)(R * K + C) * 2u; voffB[i] = (unsigned)(Rb * K + C) * 2u; }
    const size_t kstep = (size_t)(BK * 2);
    const size_t hstep = (size_t)HALF * K * 2;
    const size_t tstep = 2 * hstep;
    const unsigned ldsw = (unsigned)wid * 1024u;
    const int aoff = lds_byte(wr * 64 + fr, fq * 8), boff = lds_byte(wc * 32 + fr, fq * 8);
#define PG8_SA(b, h) (((b) * 2 + (h)) * HTB)
#define PG8_SB(b, h) ((4 + (b) * 2 + (h)) * HTB)
#define PG8_STAGE(bufoff, gbase, voff) do { _Pragma("unroll") for (int _i = 0; _i < 2; ++_i) \
        __builtin_amdgcn_global_load_lds((const unsigned*)((const char*)(gbase) + (voff)[_i]), (PG8_LAS unsigned*)(lds + (bufoff) + ldsw + _i * 8192), 16, 0, 0); } while (0)
#define PG8_LDA(dst, b, h) do { _Pragma("unroll") for (int m = 0; m < 4; ++m) _Pragma("unroll") for (int k = 0; k < 2; ++k) dst[m][k] = *(const PG8_LAS bf16x8*)(lds + PG8_SA(b, h) + aoff + m * 2048 + k * 1024); } while (0)
#define PG8_LDB(dst, b, h) do { _Pragma("unroll") for (int n = 0; n < 2; ++n) _Pragma("unroll") for (int k = 0; k < 2; ++k) dst[n][k] = *(const PG8_LAS bf16x8*)(lds + PG8_SB(b, h) + boff + n * 2048 + k * 1024); } while (0)
#define PG8_MMA(ai, bj, At, Bt) do { __builtin_amdgcn_s_setprio(1); _Pragma("unroll") for (int m = 0; m < 4; ++m) _Pragma("unroll") for (int n = 0; n < 2; ++n) _Pragma("unroll") for (int k = 0; k < 2; ++k) \
        acc[ai][bj][m][n] = __builtin_amdgcn_mfma_f32_16x16x32_bf16(Bt[n][k], At[m][k], acc[ai][bj][m][n], 0, 0, 0); __builtin_amdgcn_s_setprio(0); } while (0)
#define PG8_WAIT_V(n) asm volatile("s_waitcnt vmcnt(" #n ")" ::: "memory")
#define PG8_WAIT_L(n) asm volatile("s_waitcnt lgkmcnt(" #n ")" ::: "memory")
#define PG8_BAR __builtin_amdgcn_s_barrier()
#define PG8_SCHED __builtin_amdgcn_sched_barrier(0)
    Unit cur, nxt; int ui = 0;
    if (!S.next(0, cur)) return;
    f32x4 acc[2][2][4][2];
#pragma unroll
    for (int a = 0; a < 2; ++a)
#pragma unroll
        for (int b = 0; b < 2; ++b)
#pragma unroll
            for (int m = 0; m < 4; ++m)
#pragma unroll
                for (int n = 0; n < 2; ++n) acc[a][b][m][n] = (f32x4){0.f, 0.f, 0.f, 0.f};
    bf16x8 At[4][2], B0[2][2], B1[2][2];
    const char* cA = (const char*)g.A + (size_t)cur.pm * tstep; const char* cB = (const char*)g.Bt + (size_t)cur.pn * tstep;
    S.a_ready(cur);
    if constexpr (SP2) {
        PG8_STAGE(PG8_SB(0, 0), cB, voffB); PG8_STAGE(PG8_SB(0, 1), cB + hstep, voffB); PG8_STAGE(PG8_SA(0, 0), cA, voffA); PG8_STAGE(PG8_SA(0, 1), cA + hstep, voffA);
        if (wr == 1) PG8_BAR;
        PG8_WAIT_V(2); PG8_BAR;
        PG8_STAGE(PG8_SB(1, 0), cB + kstep, voffB); PG8_STAGE(PG8_SA(1, 0), cA + kstep, voffA); PG8_STAGE(PG8_SB(1, 1), cB + hstep + kstep, voffB);
        PG8_WAIT_V(6); PG8_BAR;
    } else {
        PG8_STAGE(PG8_SB(0, 0), cB, voffB); PG8_STAGE(PG8_SA(0, 0), cA, voffA); PG8_STAGE(PG8_SB(0, 1), cB + hstep, voffB); PG8_STAGE(PG8_SA(0, 1), cA + hstep, voffA);
        if (wr == 1) PG8_BAR;
        PG8_WAIT_V(4); PG8_BAR;
        PG8_STAGE(PG8_SB(1, 0), cB + kstep, voffB); PG8_STAGE(PG8_SA(1, 0), cA + kstep, voffA); PG8_STAGE(PG8_SB(1, 1), cB + hstep + kstep, voffB);
        PG8_WAIT_V(6); PG8_BAR;
    }
    for (;;) {
        const bool has_next = S.next(ui + 1, nxt);
        const char* nA = has_next ? (const char*)g.A + (size_t)nxt.pm * tstep : cA; const char* nB = has_next ? (const char*)g.Bt + (size_t)nxt.pn * tstep : cB;
        for (int t = 0; t < nt; t += 2) {
            const bool last = (t == nt - 2);
            const char* a1 = cA + (size_t)(t + 1) * kstep;
            const char* a2 = last ? nA : cA + (size_t)(t + 2) * kstep; const char* b2 = last ? nB : cB + (size_t)(t + 2) * kstep;
            const char* a3 = a2 + kstep; const char* b3 = b2 + kstep;
            if (last && has_next) S.a_ready(nxt);
            if constexpr (SP2) {
            PG8_LDB(B0, 0, 0); PG8_LDB(B1, 0, 1); PG8_SCHED; PG8_LDA(At, 0, 0); PG8_STAGE(PG8_SA(1, 1), a1 + hstep, voffA);
            PG8_WAIT_V(8); PG8_WAIT_L(0); PG8_BAR; PG8_MMA(0, 0, At, B0); PG8_MMA(0, 1, At, B1); PG8_BAR; PG8_SCHED;
            PG8_LDA(At, 0, 1); PG8_STAGE(PG8_SB(0, 0), b2, voffB); PG8_STAGE(PG8_SB(0, 1), b2 + hstep, voffB); PG8_STAGE(PG8_SA(0, 0), a2, voffA);
            PG8_WAIT_V(8); PG8_WAIT_L(0); PG8_BAR; PG8_MMA(1, 0, At, B0); PG8_MMA(1, 1, At, B1); PG8_BAR; PG8_SCHED;
            PG8_LDB(B0, 1, 0); PG8_LDB(B1, 1, 1); PG8_SCHED; PG8_LDA(At, 1, 0); PG8_STAGE(PG8_SA(0, 1), a2 + hstep, voffA);
            PG8_WAIT_V(8); PG8_WAIT_L(0); PG8_BAR; PG8_MMA(0, 0, At, B0); PG8_MMA(0, 1, At, B1); PG8_BAR; PG8_SCHED;
            PG8_LDA(At, 1, 1); PG8_STAGE(PG8_SB(1, 0), b3, voffB); PG8_STAGE(PG8_SB(1, 1), b3 + hstep, voffB); PG8_STAGE(PG8_SA(1, 0), a3, voffA);
            PG8_WAIT_V(8); PG8_WAIT_L(0); PG8_BAR; PG8_MMA(1, 0, At, B0); PG8_MMA(1, 1, At, B1); PG8_BAR; PG8_SCHED;
            } else {
            PG8_LDB(B0, 0, 0); PG8_SCHED; PG8_LDA(At, 0, 0); PG8_STAGE(PG8_SA(1, 1), a1 + hstep, voffA);
            PG8_WAIT_L(8); PG8_BAR; PG8_WAIT_L(0); PG8_MMA(0, 0, At, B0); PG8_BAR; PG8_SCHED;
            PG8_LDB(B1, 0, 1); PG8_STAGE(PG8_SB(0, 0), b2, voffB);
            PG8_BAR; PG8_WAIT_L(0); PG8_MMA(0, 1, At, B1); PG8_BAR;
            PG8_LDA(At, 0, 1); PG8_STAGE(PG8_SA(0, 0), a2, voffA);
            PG8_BAR; PG8_WAIT_L(0); PG8_MMA(1, 0, At, B0); PG8_BAR; PG8_SCHED;
            PG8_STAGE(PG8_SB(0, 1), b2 + hstep, voffB);
            PG8_WAIT_V(6); PG8_BAR; PG8_MMA(1, 1, At, B1); PG8_BAR;
            PG8_LDB(B0, 1, 0); PG8_SCHED; PG8_LDA(At, 1, 0); PG8_STAGE(PG8_SA(0, 1), a2 + hstep, voffA);
            PG8_WAIT_L(8); PG8_BAR; PG8_WAIT_L(0); PG8_MMA(0, 0, At, B0); PG8_BAR; PG8_SCHED;
            PG8_LDB(B1, 1, 1); PG8_STAGE(PG8_SB(1, 0), b3, voffB);
            PG8_BAR; PG8_WAIT_L(0); PG8_MMA(0, 1, At, B1); PG8_BAR;
            PG8_LDA(At, 1, 1); PG8_STAGE(PG8_SA(1, 0), a3, voffA);
            PG8_BAR; PG8_WAIT_L(0); PG8_MMA(1, 0, At, B0); PG8_BAR; PG8_SCHED;
            PG8_STAGE(PG8_SB(1, 1), b3 + hstep, voffB);
            PG8_WAIT_V(6); PG8_BAR; PG8_MMA(1, 1, At, B1); PG8_BAR;
            }
        }
        if constexpr (ALIGN_EPI) { if (wr == 0) PG8_BAR; }
        if constexpr (!Epi::AFTER_DRAIN) { E(acc, cur, wr, wc, fr, fq); S.done(cur); }
        if (!has_next) break;
#pragma unroll
        for (int a = 0; a < 2; ++a)
#pragma unroll
            for (int b = 0; b < 2; ++b)
#pragma unroll
                for (int m = 0; m < 4; ++m)
#pragma unroll
                    for (int n = 0; n < 2; ++n) acc[a][b][m][n] = (f32x4){0.f, 0.f, 0.f, 0.f};
        cur = nxt; cA = nA; cB = nB; ++ui;
        if constexpr (ALIGN_EPI) { if (wr == 1) PG8_BAR; }
    }
    PG8_WAIT_V(0);
    if constexpr (!ALIGN_EPI) { if (wr == 0) PG8_BAR; }
    PG8_BAR;
    if constexpr (Epi::AFTER_DRAIN) { E.fused(acc, cur, wr, wc, fr, fq, lds, wid, lane); S.done(cur); }
#undef PG8_SA
#undef PG8_SB
#undef PG8_STAGE
#undef PG8_LDA
#undef PG8_LDB
#undef PG8_MMA
#undef PG8_WAIT_V
#undef PG8_WAIT_L
#undef PG8_BAR
#undef PG8_SCHED
}
}
using pg8::bf16x8; using pg8::f32x4; using pg8::u32x4;

constexpr size_t MiB = 1u << 20;
constexpr size_t WS_CTL = 0, CTL_ZERO_BYTES = 64 * 1024;
constexpr size_t WS_WIN = 1 * MiB;
constexpr size_t WS_WAB = 19 * MiB;
constexpr size_t WS_WO = 23 * MiB;
constexpr size_t WS_WGU = 25 * MiB;
constexpr size_t WS_WD = 36 * MiB;
constexpr size_t WS_XN = 48 * MiB;
constexpr size_t WS_MERGED = WS_XN;
constexpr size_t WS_RSTD1 = 113 * MiB;
constexpr size_t WS_BETA = 114 * MiB;
constexpr size_t WS_G = 116 * MiB;
constexpr size_t WS_RSS = 118 * MiB;
constexpr size_t WS_PARTO = 121 * MiB;
constexpr size_t WS_PARTL = 129 * MiB;
constexpr size_t WS_QKW = 129 * MiB + 512 * 1024;
constexpr size_t WS_QB = 130 * MiB;
constexpr size_t WS_KB = 195 * MiB;
constexpr size_t WS_VB = 260 * MiB;
constexpr size_t WS_X1B = WS_QB;
constexpr size_t WS_DQKV = 325 * MiB;
constexpr size_t WS_OAB = WS_DQKV;
constexpr size_t WS_QKVC = 520 * MiB;
constexpr size_t WS_ACT = WS_QKVC;
constexpr size_t WS_DG = 715 * MiB;
constexpr size_t WS_GA = 780 * MiB;
constexpr size_t WS_GB = 845 * MiB;
constexpr size_t WS_END = 910 * MiB;
constexpr int CW_Q2 = 64, CW_Q3 = 128;

constexpr int LDS_BYTES = 147456;
constexpr int NWAVES = 8, NTHREADS = 512;

typedef unsigned short bf16;
__device__ __forceinline__ unsigned pk2(float lo, float hi) { f32x2 v = {lo, hi}; bf16x2_t b = __builtin_convertvector(v, bf16x2_t); return __builtin_bit_cast(unsigned, b); }
__device__ __forceinline__ float bflo(unsigned w) { return __uint_as_float(w << 16); }
__device__ __forceinline__ float bfhi(unsigned w) { return __uint_as_float(w & 0xffff0000u); }
__device__ __forceinline__ float bf1(unsigned short h) { return __uint_as_float((unsigned)h << 16); }
__device__ __forceinline__ float wave_sum(float v) {
#pragma unroll
    for (int o = 1; o < 64; o <<= 1) v += __shfl_xor(v, o);
    return v;
}
__device__ __forceinline__ float sigmoidf_(float x) { return 1.f / (1.f + __expf(-x)); }
#define LDS_WAIT() asm volatile("s_waitcnt lgkmcnt(0)" ::: "memory")

struct Args {
    const float* in[25]; float* out; unsigned char* ws; int ph_lo, ph_hi;
};

struct Frame {
    LAS unsigned char* lds;
    unsigned char* ws; float* out;
    const float* const* in;
    int tid, lane, wave, G, bid;
};

__device__ __forceinline__ void tr_item(const float* W, int Nsrc, int scol0, int k0, bf16* WT, int K, int drow0, const float* ksc, LAS float* scr, int lane) {
#pragma unroll 8
    for (int i = 0; i < 32; ++i) { const int kk = 2 * i + (lane >> 5); float v = W[(size_t)(k0 + kk) * Nsrc + scol0 + (lane & 31)]; if (ksc) v *= ksc[k0 + kk]; scr[kk * 33 + (lane & 31)] = v; }
    LDS_WAIT(); asm volatile("" ::: "memory");
    const int c = lane & 7;
#pragma unroll
    for (int j = 0; j < 4; ++j) { const int n = (lane >> 3) + 8 * j; const LAS float* s = scr + (8 * c) * 33 + n;
        u32x4 o; o.x = pk2(s[0 * 33], s[1 * 33]); o.y = pk2(s[2 * 33], s[3 * 33]); o.z = pk2(s[4 * 33], s[5 * 33]); o.w = pk2(s[6 * 33], s[7 * 33]);
        *(u32x4*)(WT + (size_t)(drow0 + n) * K + k0 + 8 * c) = o; }
    LDS_WAIT(); asm volatile("" ::: "memory");
}

__device__ __forceinline__ void p0_prologue(const Frame& F) {
    const float* xp = F.in[0]; const float* xs = F.in[1]; const float* ln1 = F.in[6]; const float* w_in = F.in[7];
    const float* w_a = F.in[15]; const float* w_b = F.in[20]; const float* w_o = F.in[21]; const float* ln2 = F.in[22]; const float* w_gu = F.in[23]; const float* w_d = F.in[24];
    const float* a_log = F.in[17]; const float* dt_bias = F.in[18];
    bf16* WinT = (bf16*)(F.ws + WS_WIN); bf16* WabT = (bf16*)(F.ws + WS_WAB); bf16* WoT = (bf16*)(F.ws + WS_WO); bf16* WguT = (bf16*)(F.ws + WS_WGU); bf16* WdT = (bf16*)(F.ws + WS_WD);
    bf16* XN = (bf16*)(F.ws + WS_XN); float* RSTD1 = (float*)(F.ws + WS_RSTD1); float* BETA = (float*)(F.ws + WS_BETA); float* GARR = (float*)(F.ws + WS_G);
    LAS bf16* W16h = (LAS bf16*)(F.lds); LAS bf16* W16l = (LAS bf16*)(F.lds + 32768);
    LAS float* scr = (LAS float*)(F.lds + 65536 + F.wave * 8448);
    for (int idx = F.tid; idx < 16384; idx += NTHREADS) { const int k = idx >> 4, c = idx & 15; const float v = w_in[(size_t)k * DIN + 7168 + c] * ln1[k];
        const unsigned hi = pk2(v, 0.f) & 0xffffu; const float r = v - bf1((unsigned short)hi); const unsigned lo = pk2(r, 0.f) & 0xffffu;
        const int off = ((((k >> 5) * 4 + ((k >> 3) & 3)) * 16 + c) << 3) + (k & 7); W16h[off] = (bf16)hi; W16l[off] = (bf16)lo; }
    if (F.bid == 0 && F.tid < 128) ((float*)(F.ws + WS_QKW))[F.tid] = F.tid < 64 ? F.in[8][F.tid] : F.in[9][F.tid - 64];
    const int gw = F.bid * NWAVES + F.wave, NGW = F.G * NWAVES;
    constexpr int I_IN = 16 * (NZ / 32), I_AB = 16 * 64, I_O = 16 * 32, I_GU = 16 * (2 * DFF / 32), I_D = (DFF / 64) * 32;
    constexpr int NITEMS = I_IN + I_AB + I_O + I_GU + I_D;
    for (int it = gw; it < NITEMS; it += NGW) {
        int r = it;
        if (r < I_IN) { const int kb = r / (NZ / 32), nb = r % (NZ / 32); const int n = nb * 32, pn = n >> 8, T = n & 255, bj = T >> 7, g = (T & 127) >> 5; const int zc = 256 * pn + 64 * g + 32 * bj;
            tr_item(w_in, DIN, zc < 7168 ? zc : zc + 16, kb * 64, WinT, DM, n, ln1, scr, F.lane); continue; } r -= I_IN;
        if (r < I_AB) { const int kb = r / 64, nb = r % 64; const int n = nb * 32; tr_item(n < 1024 ? w_a : w_b, DM, n & 1023, kb * 64, WabT, DM, n, nullptr, scr, F.lane); continue; } r -= I_AB;
        if (r < I_O) { const int kb = r / 32, nb = r % 32; tr_item(w_o, DM, nb * 32, kb * 64, WoT, DM, nb * 32, nullptr, scr, F.lane); continue; } r -= I_O;
        if (r < I_GU) { const int kb = r / (2 * DFF / 32), nb = r % (2 * DFF / 32); const int n = nb * 32, pn = n >> 8, T = n & 255, bj = T >> 7, cc = T & 127;
            tr_item(w_gu, 2 * DFF, bj * DFF + 128 * pn + cc, kb * 64, WguT, DM, n, ln2, scr, F.lane); continue; } r -= I_GU;
        { const int kb = r / 32, nb = r % 32; tr_item(w_d, DM, nb * 32, kb * 64, WdT, DFF, nb * 32, nullptr, scr, F.lane); }
    }
    __syncthreads();
    const int fr = F.lane & 15, fq = F.lane >> 4;
    for (int grp = gw; grp < MT / 16; grp += NGW) {
        const int row = grp * 16 + fr;
        const float* xr = (row < MP ? xp + (size_t)row * DM : xs + (size_t)(row - MP) * DM) + 8 * fq;
        bf16* xo = XN + (size_t)row * DM + 8 * fq;
        f32x4 acc = {0.f, 0.f, 0.f, 0.f}; float ss = 0.f;
#pragma unroll 4
        for (int s = 0; s < 32; ++s) {
            const f32x4 a = *(const f32x4*)(xr + 32 * s), b = *(const f32x4*)(xr + 32 * s + 4);
            ss += (a.x * a.x + a.y * a.y) + (a.z * a.z + a.w * a.w) + (b.x * b.x + b.y * b.y) + (b.z * b.z + b.w * b.w);
            u32x4 hw; hw.x = pk2(a.x, a.y); hw.y = pk2(a.z, a.w); hw.z = pk2(b.x, b.y); hw.w = pk2(b.z, b.w);
            *(u32x4*)(xo + 32 * s) = hw;
            u32x4 lw; lw.x = pk2(a.x - bflo(hw.x), a.y - bfhi(hw.x)); lw.y = pk2(a.z - bflo(hw.y), a.w - bfhi(hw.y)); lw.z = pk2(b.x - bflo(hw.z), b.y - bfhi(hw.z)); lw.w = pk2(b.z - bflo(hw.w), b.w - bfhi(hw.w));
            const bf16x8 wh = *(const LAS bf16x8*)(W16h + (((s * 4 + fq) * 16 + fr) << 3)), wl = *(const LAS bf16x8*)(W16l + (((s * 4 + fq) * 16 + fr) << 3));
            const bf16x8 xh = __builtin_bit_cast(bf16x8, hw), xl = __builtin_bit_cast(bf16x8, lw);
            acc = __builtin_amdgcn_mfma_f32_16x16x32_bf16(wh, xh, acc, 0, 0, 0);
            acc = __builtin_amdgcn_mfma_f32_16x16x32_bf16(wh, xl, acc, 0, 0, 0);
            acc = __builtin_amdgcn_mfma_f32_16x16x32_bf16(wl, xh, acc, 0, 0, 0);
        }
        ss += __shfl_xor(ss, 16); ss += __shfl_xor(ss, 32);
        const float rstd = rsqrtf(ss * (1.f / DM) + EPS);
        if (fq == 0) RSTD1[row] = rstd;
        if (fq < 2) { f32x4 o; o.x = sigmoidf_(acc.x * rstd); o.y = sigmoidf_(acc.y * rstd); o.z = sigmoidf_(acc.z * rstd); o.w = sigmoidf_(acc.w * rstd); *(f32x4*)(BETA + (size_t)row * 8 + 4 * fq) = o; }
        else { const int h0 = 4 * (fq - 2); f32x4 o;
#pragma unroll
            for (int i = 0; i < 4; ++i) { const float z = acc[i] * rstd + dt_bias[h0 + i]; const float sp = z > 20.f ? z : log1pf(__expf(z)); o[i] = -__expf(a_log[h0 + i]) * sp; }
            *(f32x4*)(GARR + (size_t)row * 8 + h0) = o; }
    }
}

namespace pg8 {
struct PairOrder {
    int G, c;
    __device__ bool next(int i, Unit& u) const { const int P = (i >> 1) * G + c; if (P >= 130 * 4) return false; const int s = i & 1; u.pm = (P >> 2) + 130 * s; u.pn = (P & 3) + 4 * s; return true; }
    __device__ __forceinline__ void a_ready(const Unit&) const {}
    __device__ __forceinline__ void done(const Unit&) const {}
};

struct EpiZ {
    static constexpr bool PERM = true, AFTER_DRAIN = false;
    unsigned char* ws; float* out;
    __device__ __forceinline__ void operator()(const f32x4 (&acc)[2][2][4][2], const Unit& u, int wr, int wc, int fr, int fq) const {
        const int pn = u.pn, row0 = u.pm * BM + wr * 64 + fr;
        const float* rstd = (const float*)(ws + WS_RSTD1);
        f32x4 wv[2][2];
        if (pn < 8) { const float* w = (const float*)(ws + WS_QKW) + (pn < 4 ? 0 : 64); const float sc = pn < 4 ? QSCALE : 1.f;
#pragma unroll
            for (int bj = 0; bj < 2; ++bj)
#pragma unroll
                for (int n = 0; n < 2; ++n) wv[bj][n] = *(const f32x4*)(w + 32 * bj + 8 * fq + 4 * n) * sc; }
#pragma unroll
        for (int ai = 0; ai < 2; ++ai)
#pragma unroll
            for (int m = 0; m < 4; ++m) {
                const int row = row0 + ai * HALF + m * 16; const float rs = rstd[row];
                f32x4 v[2][2];
#pragma unroll
                for (int bj = 0; bj < 2; ++bj)
#pragma unroll
                    for (int n = 0; n < 2; ++n) v[bj][n] = acc[ai][bj][m][n] * rs;
                const int lc = 64 * wc + 8 * fq;
                if (pn < 8) {
                    float ss = 0.f;
#pragma unroll
                    for (int bj = 0; bj < 2; ++bj)
#pragma unroll
                        for (int n = 0; n < 2; ++n) ss += (v[bj][n].x * v[bj][n].x + v[bj][n].y * v[bj][n].y) + (v[bj][n].z * v[bj][n].z + v[bj][n].w * v[bj][n].w);
                    ss += __shfl_xor(ss, 16); ss += __shfl_xor(ss, 32);
                    const float r = rsqrtf(ss * (1.f / 64.f) + EPS);
                    bf16_t* dst = (bf16_t*)(ws + (pn < 4 ? WS_QB : WS_KB)) + (size_t)row * DM + (pn & 3) * 256 + lc;
                    float* ko = out + (row < MP ? OFF_KP + (size_t)row * DM : OFF_KS + (size_t)(row - MP) * DM) + (pn & 3) * 256 + lc;
#pragma unroll
                    for (int bj = 0; bj < 2; ++bj) { const f32x4 o0 = v[bj][0] * r * wv[bj][0], o1 = v[bj][1] * r * wv[bj][1];
                        u32x4 w; w.x = pk2(o0.x, o0.y); w.y = pk2(o0.z, o0.w); w.z = pk2(o1.x, o1.y); w.w = pk2(o1.z, o1.w);
                        *(u32x4*)(dst + 32 * bj) = w;
                        if (pn >= 4) { *(f32x4*)(ko + 32 * bj) = o0; *(f32x4*)(ko + 32 * bj + 4) = o1; } }
                } else if (pn < 12) {
                    bf16_t* dst = (bf16_t*)(ws + WS_VB) + (size_t)row * DM + (pn - 8) * 256 + lc;
                    float* vo = out + (row < MP ? OFF_VP + (size_t)row * DM : OFF_VS + (size_t)(row - MP) * DM) + (pn - 8) * 256 + lc;
#pragma unroll
                    for (int bj = 0; bj < 2; ++bj) { u32x4 w; w.x = pk2(v[bj][0].x, v[bj][0].y); w.y = pk2(v[bj][0].z, v[bj][0].w); w.z = pk2(v[bj][1].x, v[bj][1].y); w.w = pk2(v[bj][1].z, v[bj][1].w);
                        *(u32x4*)(dst + 32 * bj) = w; *(f32x4*)(vo + 32 * bj) = v[bj][0]; *(f32x4*)(vo + 32 * bj + 4) = v[bj][1]; }
                } else if (pn < 24) {
                    const int col = (pn - 12) * 256 + lc; bf16_t* dst = (bf16_t*)(ws + WS_DQKV) + (size_t)row * CONVCH + col;
                    int cr = -1; float* co = nullptr;
                    if (row < MP) { const int t = row & (SEQ - 1); if (t >= SEQ - 3) { cr = t - (SEQ - 3); co = out + OFF_CP + ((size_t)(row >> 11) * 3 + cr) * CONVCH + col; } }
                    else { const int t = (row - MP) & (DSEQ - 1); if (t >= DSEQ - 3) { cr = t - (DSEQ - 3); co = out + OFF_CS + ((size_t)((row - MP) >> 5) * 3 + cr) * CONVCH + col; } }
#pragma unroll
                    for (int bj = 0; bj < 2; ++bj) { u32x4 w; w.x = pk2(v[bj][0].x, v[bj][0].y); w.y = pk2(v[bj][0].z, v[bj][0].w); w.z = pk2(v[bj][1].x, v[bj][1].y); w.w = pk2(v[bj][1].z, v[bj][1].w);
                        *(u32x4*)(dst + 32 * bj) = w; if (cr >= 0) { *(f32x4*)(co + 32 * bj) = v[bj][0]; *(f32x4*)(co + 32 * bj + 4) = v[bj][1]; } }
                } else {
                    bf16_t* dst = (bf16_t*)(ws + (pn < 28 ? WS_DG : (pn < 32 ? WS_GA : WS_GB))) + (size_t)row * DM + (pn & 3) * 256 + lc;
                    const bool sg = pn >= 28;
#pragma unroll
                    for (int bj = 0; bj < 2; ++bj) { f32x4 a = v[bj][0], b = v[bj][1];
                        if (sg) { a.x = sigmoidf_(a.x); a.y = sigmoidf_(a.y); a.z = sigmoidf_(a.z); a.w = sigmoidf_(a.w); b.x = sigmoidf_(b.x); b.y = sigmoidf_(b.y); b.z = sigmoidf_(b.z); b.w = sigmoidf_(b.w); }
                        u32x4 w; w.x = pk2(a.x, a.y); w.y = pk2(a.z, a.w); w.z = pk2(b.x, b.y); w.w = pk2(b.z, b.w); *(u32x4*)(dst + 32 * bj) = w; }
                }
                asm volatile("" ::: "memory");
            }
    }
};

struct EpiAB {
    static constexpr bool PERM = true, AFTER_DRAIN = false;
    unsigned char* ws; float* tmp;
    __device__ __forceinline__ void operator()(const f32x4 (&acc)[2][2][4][2], const Unit& u, int wr, int wc, int fr, int fq) const {
        const int s = u.pm >= 130 ? 1 : 0; const int pm = u.pm - 130 * s, pn = u.pn - 4 * s;
        const int row0 = pm * BM + wr * 64 + fr, col0 = pn * BM + wc * 32 + 8 * fq;
        const bf16_t* G = (const bf16_t*)(ws + (s ? WS_GB : WS_GA)); bf16_t* MERGED = (bf16_t*)(ws + WS_MERGED);
#pragma unroll
        for (int ai = 0; ai < 2; ++ai)
#pragma unroll
            for (int m = 0; m < 4; ++m) { const size_t off = (size_t)(row0 + ai * HALF + m * 16) * DM + col0;
#pragma unroll
                for (int bj = 0; bj < 2; ++bj) { const u32x4 g = *(const u32x4*)(G + off + bj * HALF);
                    f32x4 a = acc[ai][bj][m][0], b = acc[ai][bj][m][1];
                    a.x *= bflo(g.x); a.y *= bfhi(g.x); a.z *= bflo(g.y); a.w *= bfhi(g.y); b.x *= bflo(g.z); b.y *= bfhi(g.z); b.z *= bflo(g.w); b.w *= bfhi(g.w);
                    float* t = tmp + off + bj * HALF;
                    if (s == 0) { *(f32x4*)t = a; *(f32x4*)(t + 4) = b; }
                    else { a += *(const f32x4*)t; b += *(const f32x4*)(t + 4); u32x4 w; w.x = pk2(a.x, a.y); w.y = pk2(a.z, a.w); w.z = pk2(b.x, b.y); w.w = pk2(b.z, b.w); *(u32x4*)(MERGED + off + bj * HALF) = w; } } }
    }
};

struct EpiOut {
    static constexpr bool PERM = true, AFTER_DRAIN = false;
    const float* xp; const float* xs; float* out; bf16_t* X1B; float* RSS;
    __device__ __forceinline__ void operator()(const f32x4 (&acc)[2][2][4][2], const Unit& u, int wr, int wc, int fr, int fq) const {
        const int row0 = u.pm * BM + wr * 64 + fr, col0 = u.pn * BM + wc * 32 + 8 * fq;
#pragma unroll
        for (int ai = 0; ai < 2; ++ai)
#pragma unroll
            for (int m = 0; m < 4; ++m) { const int row = row0 + ai * HALF + m * 16; const size_t off = (size_t)row * DM + col0;
                const float* xr = (row < MP ? xp + (size_t)row * DM : xs + (size_t)(row - MP) * DM) + col0; float ss = 0.f;
#pragma unroll
                for (int bj = 0; bj < 2; ++bj) { const f32x4 a = acc[ai][bj][m][0] + *(const f32x4*)(xr + bj * HALF), b = acc[ai][bj][m][1] + *(const f32x4*)(xr + bj * HALF + 4);
                    ss += (a.x * a.x + a.y * a.y) + (a.z * a.z + a.w * a.w) + (b.x * b.x + b.y * b.y) + (b.z * b.z + b.w * b.w);
                    *(f32x4*)(out + off + bj * HALF) = a; *(f32x4*)(out + off + bj * HALF + 4) = b;
                    u32x4 w; w.x = pk2(a.x, a.y); w.y = pk2(a.z, a.w); w.z = pk2(b.x, b.y); w.w = pk2(b.z, b.w); *(u32x4*)(X1B + off + bj * HALF) = w; }
                ss += __shfl_xor(ss, 16); ss += __shfl_xor(ss, 32);
                if (fq == 0) RSS[(size_t)row * 16 + u.pn * 4 + wc] = ss; }
    }
};

struct EpiGU {
    static constexpr bool PERM = true, AFTER_DRAIN = false;
    const float* RSS; bf16_t* ACT;
    __device__ __forceinline__ void operator()(const f32x4 (&acc)[2][2][4][2], const Unit& u, int wr, int wc, int fr, int fq) const {
        const int row0 = u.pm * BM + wr * 64 + fr, col0 = u.pn * 128 + wc * 32 + 8 * fq;
#pragma unroll
        for (int ai = 0; ai < 2; ++ai)
#pragma unroll
            for (int m = 0; m < 4; ++m) { const int row = row0 + ai * HALF + m * 16;
                const f32x4* rp = (const f32x4*)(RSS + (size_t)row * 16); const f32x4 r0 = rp[0], r1 = rp[1], r2 = rp[2], r3 = rp[3];
                const float ss = ((r0.x + r0.y) + (r0.z + r0.w)) + ((r1.x + r1.y) + (r1.z + r1.w)) + ((r2.x + r2.y) + (r2.z + r2.w)) + ((r3.x + r3.y) + (r3.z + r3.w));
                const float rs = rsqrtf(ss * (1.f / DM) + EPS);
                f32x4 o[2];
#pragma unroll
                for (int n = 0; n < 2; ++n) { const f32x4 g = acc[ai][0][m][n] * rs, uu = acc[ai][1][m][n] * rs;
                    o[n].x = g.x * sigmoidf_(g.x) * uu.x; o[n].y = g.y * sigmoidf_(g.y) * uu.y; o[n].z = g.z * sigmoidf_(g.z) * uu.z; o[n].w = g.w * sigmoidf_(g.w) * uu.w; }
                u32x4 w; w.x = pk2(o[0].x, o[0].y); w.y = pk2(o[0].z, o[0].w); w.z = pk2(o[1].x, o[1].y); w.w = pk2(o[1].z, o[1].w);
                *(u32x4*)(ACT + (size_t)row * DFF + col0) = w; }
    }
};

struct EpiDown {
    static constexpr bool PERM = true, AFTER_DRAIN = false;
    float* out;
    __device__ __forceinline__ void operator()(const f32x4 (&acc)[2][2][4][2], const Unit& u, int wr, int wc, int fr, int fq) const {
        const int row0 = u.pm * BM + wr * 64 + fr, col0 = u.pn * BM + wc * 32 + 8 * fq;
#pragma unroll
        for (int ai = 0; ai < 2; ++ai)
#pragma unroll
            for (int m = 0; m < 4; ++m) { float* o = out + (size_t)(row0 + ai * HALF + m * 16) * DM + col0;
#pragma unroll
                for (int bj = 0; bj < 2; ++bj) { *(f32x4*)(o + bj * HALF) = *(const f32x4*)(o + bj * HALF) + acc[ai][bj][m][0]; *(f32x4*)(o + bj * HALF + 4) = *(const f32x4*)(o + bj * HALF + 4) + acc[ai][bj][m][1]; } }
    }
};
}

__device__ __forceinline__ float lambda_of(const Frame& F) {
    const float* q1 = F.in[10]; const float* k1 = F.in[11]; const float* q2 = F.in[12]; const float* k2 = F.in[13];
    float a = 0.f, b = 0.f;
    for (int i = 0; i < 64; ++i) { a += q1[i] * k1[i]; b += q2[i] * k2[i]; }
    return __expf(a) - __expf(b) + LAM_INIT;
}

__device__ __forceinline__ void conv_task(const Frame& F, int task) {
    const bf16* DQKV = (const bf16*)(F.ws + WS_DQKV); bf16* QKVC = (bf16*)(F.ws + WS_QKVC);
    const float* conv_w = F.in[16]; const float* sconv = F.in[5];
    int lane_ = F.lane; asm volatile("" : "+v"(lane_)); const int run = task / 6, cgp = task % 6; const int c0 = cgp * 512 + lane_ * 8; const int r0 = run * 32;
    const bool sample = r0 >= MP; const int t0 = sample ? 0 : (r0 & (SEQ - 1));
    float w[4][8];
#pragma unroll
    for (int j = 0; j < 4; ++j) { const f32x4 a = *(const f32x4*)(conv_w + j * CONVCH + c0), b = *(const f32x4*)(conv_w + j * CONVCH + c0 + 4); w[j][0] = a.x; w[j][1] = a.y; w[j][2] = a.z; w[j][3] = a.w; w[j][4] = b.x; w[j][5] = b.y; w[j][6] = b.z; w[j][7] = b.w; }
    float h[3][8];
#pragma unroll
    for (int j = 0; j < 3; ++j) {
        if (t0 > 0) { const u32x4 v = *(const u32x4*)(DQKV + (size_t)(r0 - 3 + j) * CONVCH + c0); h[j][0] = bflo(v.x); h[j][1] = bfhi(v.x); h[j][2] = bflo(v.y); h[j][3] = bfhi(v.y); h[j][4] = bflo(v.z); h[j][5] = bfhi(v.z); h[j][6] = bflo(v.w); h[j][7] = bfhi(v.w); }
        else if (sample) { const float* s = sconv + ((size_t)((r0 - MP) >> 5) * 3 + j) * CONVCH + c0; const f32x4 a = *(const f32x4*)s, b = *(const f32x4*)(s + 4); h[j][0] = a.x; h[j][1] = a.y; h[j][2] = a.z; h[j][3] = a.w; h[j][4] = b.x; h[j][5] = b.y; h[j][6] = b.z; h[j][7] = b.w; }
        else {
#pragma unroll
            for (int e = 0; e < 8; ++e) h[j][e] = 0.f; }
    }
    const float qs = cgp < 2 ? 0.08838834764831845f : 1.f; const bool nrm = cgp < 4;
    for (int t = 0; t < 32; ++t) {
        const u32x4 v = *(const u32x4*)(DQKV + (size_t)(r0 + t) * CONVCH + c0);
        float x[8]; x[0] = bflo(v.x); x[1] = bfhi(v.x); x[2] = bflo(v.y); x[3] = bfhi(v.y); x[4] = bflo(v.z); x[5] = bfhi(v.z); x[6] = bflo(v.w); x[7] = bfhi(v.w);
        float y[8]; float ss = 0.f;
#pragma unroll
        for (int e = 0; e < 8; ++e) { float a = w[0][e] * h[0][e] + w[1][e] * h[1][e] + w[2][e] * h[2][e] + w[3][e] * x[e]; a = a * sigmoidf_(a); y[e] = a; ss += a * a; h[0][e] = h[1][e]; h[1][e] = h[2][e]; h[2][e] = x[e]; }
        if (nrm) { ss += __shfl_xor(ss, 1); ss += __shfl_xor(ss, 2); ss += __shfl_xor(ss, 4); ss += __shfl_xor(ss, 8); const float r = rsqrtf(ss + EPS) * qs;
#pragma unroll
            for (int e = 0; e < 8; ++e) y[e] *= r; }
        u32x4 o; o.x = pk2(y[0], y[1]); o.y = pk2(y[2], y[3]); o.z = pk2(y[4], y[5]); o.w = pk2(y[6], y[7]);
        *(u32x4*)(QKVC + (size_t)(r0 + t) * CONVCH + c0) = o;
    }
}

__device__ __forceinline__ int swz_f(int r) { return ((r & 3) << 2) | ((r >> 2) & 3); }
__device__ __forceinline__ int tile_off(int r, int ch) { return 256 * r + 16 * (ch ^ swz_f(r)); }
__device__ __forceinline__ s16x4 vtr(const LAS unsigned char* p) { typedef short v4i16_t __attribute__((ext_vector_type(4))); return __builtin_bit_cast(s16x4, __builtin_amdgcn_ds_read_tr16_b64_v4i16((LAS v4i16_t*)p)); }
__device__ __forceinline__ float exp2_(float x) { return __builtin_amdgcn_exp2f(x); }

__device__ __forceinline__ f32x16 qk_block(const LAS unsigned char* KT, int kb, int m, const bf16x8 (&qf)[4], int r, int hh) {
    f32x16 s = {0.f, 0.f, 0.f, 0.f, 0.f, 0.f, 0.f, 0.f, 0.f, 0.f, 0.f, 0.f, 0.f, 0.f, 0.f, 0.f};
    const int key = 32 * kb + r; const int fz = swz_f(key);
#pragma unroll
    for (int d0 = 0; d0 < 4; ++d0) { const bf16x8 kf = *(const LAS bf16x8*)(KT + 256 * key + 16 * ((8 * m + 2 * d0 + hh) ^ fz)); s = __builtin_amdgcn_mfma_f32_32x32x16_bf16(kf, qf[d0], s, 0, 0, 0); }
    return s;
}
__device__ __forceinline__ float exp_block(f32x16& s) { float a = 0.f;
#pragma unroll
    for (int i = 0; i < 16; ++i) { s[i] = exp2_(s[i]); a += s[i]; }
    return a; }
__device__ __forceinline__ bf16x8 pfrag(const f32x16& p, int s) { u32x4 w; w.x = pk2(p[8 * s + 0], p[8 * s + 1]); w.y = pk2(p[8 * s + 2], p[8 * s + 3]); w.z = pk2(p[8 * s + 4], p[8 * s + 5]); w.w = pk2(p[8 * s + 6], p[8 * s + 7]); return __builtin_bit_cast(bf16x8, w); }
__device__ __forceinline__ bf16x8 vfrag(const LAS unsigned char* VT, int eb, int kb, int s, int lane) {
    const int hh = lane >> 5, gsel = (lane >> 4) & 1, q = (lane >> 2) & 3, p = lane & 3;
    const int row = 32 * kb + 16 * s + 4 * hh + q; const int ch = 4 * eb + 2 * gsel + (p >> 1);
    const s16x4 lo = vtr(VT + 256 * row + 16 * (ch ^ swz_f(row)) + 8 * (p & 1));
    const s16x4 hi = vtr(VT + 256 * (row + 8) + 16 * (ch ^ swz_f(row + 8)) + 8 * (p & 1));
    return (bf16x8){lo[0], lo[1], lo[2], lo[3], hi[0], hi[1], hi[2], hi[3]};
}

template <int BUF> __device__ __forceinline__ void attn_tile(const LAS unsigned char* L, f32x16 (&O)[4], float& l, const bf16x8 (&qf)[4], int krow, int fzm, const int (&vb)[4][2]) {
    const LAS unsigned char* KT = L + BUF * 32768; const LAS unsigned char* VT = KT + 16384;
    bf16x8 p[2][2];
#pragma unroll
    for (int kb = 0; kb < 2; ++kb) {
        f32x16 s;
#pragma unroll
        for (int i = 0; i < 16; ++i) s[i] = 0.f;
#pragma unroll
        for (int d0 = 0; d0 < 4; ++d0) { const bf16x8 kf = *(const LAS bf16x8*)(KT + krow + 8192 * kb + 16 * ((2 * d0) ^ fzm)); s = __builtin_amdgcn_mfma_f32_32x32x16_bf16(kf, qf[d0], s, 0, 0, 0); }
        l += exp_block(s);
        p[kb][0] = pfrag(s, 0); p[kb][1] = pfrag(s, 1);
    }
#pragma unroll
    for (int eb = 0; eb < 4; ++eb) {
#pragma unroll
        for (int kb = 0; kb < 2; ++kb)
#pragma unroll
            for (int s = 0; s < 2; ++s) {
                const s16x4 lo = vtr(VT + vb[eb][0] + 8192 * kb + 4096 * s), hi = vtr(VT + vb[eb][1] + 8192 * kb + 4096 * s);
                O[eb] = __builtin_amdgcn_mfma_f32_32x32x16_bf16((bf16x8){lo[0], lo[1], lo[2], lo[3], hi[0], hi[1], hi[2], hi[3]}, p[kb][s], O[eb], 0, 0, 0); }
    }
}
__device__ __forceinline__ void attn_prompt_unit(const Frame& F, int b, int h, int qb, float lam) {
    const bf16* Qb = (const bf16*)(F.ws + WS_QB); const bf16* Kb = (const bf16*)(F.ws + WS_KB); const bf16* Vb = (const bf16*)(F.ws + WS_VB); bf16* OA = (bf16*)(F.ws + WS_OAB);
    const float* subw = F.in[14];
    int lane = F.lane; asm volatile("" : "+v"(lane)); const int w = F.wave, r = lane & 31, hh = lane >> 5, g = w & 3, m = w >> 2;
    const size_t rowbase = (size_t)b * SEQ; const int q0 = 128 * qb + 32 * g;
    const int NT = 2 * qb + 2, tmax = 2 * qb + (g >> 1);
    const LAS unsigned char* L = F.lds;
    bf16x8 qf[4];
#pragma unroll
    for (int d0 = 0; d0 < 4; ++d0) qf[d0] = *(const bf16x8*)(Qb + (rowbase + q0 + r) * DM + h * 128 + m * 64 + 16 * d0 + 8 * hh);
    const int fzm = swz_f(r) ^ hh ^ (8 * m); const int krow = 256 * r;
    int vb[4][2];
    { const int gsel = (lane >> 4) & 1, q = (lane >> 2) & 3, p = lane & 3;
#pragma unroll
      for (int eb = 0; eb < 4; ++eb)
#pragma unroll
          for (int hl = 0; hl < 2; ++hl) { const int row = 4 * hh + q + 8 * hl; vb[eb][hl] = 256 * row + 16 * ((4 * eb + 2 * gsel + (p >> 1)) ^ swz_f(row)) + 8 * (p & 1); } }
    f32x16 O[4];
#pragma unroll
    for (int eb = 0; eb < 4; ++eb)
#pragma unroll
        for (int i = 0; i < 16; ++i) O[eb][i] = 0.f;
    float l = 0.f;
    const bf16* kg[2]; const bf16* vg[2];
#pragma unroll
    for (int i = 0; i < 2; ++i) { const int row = 4 * (2 * w + i) + (lane >> 4), ch = (lane & 15) ^ swz_f(row); kg[i] = Kb + (rowbase + row) * DM + h * 128 + ch * 8; vg[i] = Vb + (rowbase + row) * DM + h * 128 + ch * 8; }
#define STAGE_T(t, BUF) do { const size_t o_ = (size_t)(t) * 64 * DM; _Pragma("unroll") for (int i_ = 0; i_ < 2; ++i_) { \
        __builtin_amdgcn_global_load_lds((const unsigned*)(kg[i_] + o_), (LAS unsigned*)(F.lds + (BUF) * 32768 + (2 * w + i_) * 1024), 16, 0, 0); \
        __builtin_amdgcn_global_load_lds((const unsigned*)(vg[i_] + o_), (LAS unsigned*)(F.lds + (BUF) * 32768 + 16384 + (2 * w + i_) * 1024), 16, 0, 0); } } while (0)
    __syncthreads();
    STAGE_T(0, 0);
    __syncthreads();
    for (int t = 0; t < NT; t += 2) {
        STAGE_T(t + 1, 1);
        if (t <= tmax) attn_tile<0>(L, O, l, qf, krow, fzm, vb);
        __syncthreads();
        if (t + 2 < NT) STAGE_T(t + 2, 0);
        if (t + 1 <= tmax) attn_tile<1>(L, O, l, qf, krow, fzm, vb);
        __syncthreads();
    }
#undef STAGE_T
    l += __shfl_xor(l, 32);
    LAS float* X = (LAS float*)(F.lds + 65536 + g * 16384);
    if (m == 1) { const float i1 = lam / l;
#pragma unroll
        for (int eb = 0; eb < 4; ++eb)
#pragma unroll
            for (int i = 0; i < 16; ++i) X[(eb * 16 + i) * 64 + lane] = O[eb][i] * i1; }
    __syncthreads();
    if (m == 0) { const float i0 = 1.f / l; float ss = 0.f;
#pragma unroll
        for (int eb = 0; eb < 4; ++eb)
#pragma unroll
            for (int i = 0; i < 16; ++i) { const float o = O[eb][i] * i0 - X[(eb * 16 + i) * 64 + lane]; O[eb][i] = o; ss += o * o; }
        ss += __shfl_xor(ss, 32);
        const float rs = rsqrtf(ss * (1.f / 128.f) + EPS) * (1.f - LAM_INIT);
        bf16* orow = OA + (rowbase + q0 + r) * DM + h * 128;
#pragma unroll
        for (int eb = 0; eb < 4; ++eb)
#pragma unroll
            for (int g4 = 0; g4 < 4; ++g4) { const int e = 32 * eb + 8 * g4 + 4 * hh; const f32x4 sw = *(const f32x4*)(subw + e);
                u32x2 o; o.x = pk2(O[eb][4 * g4 + 0] * rs * sw.x, O[eb][4 * g4 + 1] * rs * sw.y); o.y = pk2(O[eb][4 * g4 + 2] * rs * sw.z, O[eb][4 * g4 + 3] * rs * sw.w);
                *(u32x2*)(orow + e) = o; } }
}

__device__ __forceinline__ void attn_sample_unit(const Frame& F, int b, int h, int sp) {
    const bf16* Qb = (const bf16*)(F.ws + WS_QB); const bf16* Kb = (const bf16*)(F.ws + WS_KB); const bf16* Vb = (const bf16*)(F.ws + WS_VB);
    const float* ck = F.in[2]; const float* cv = F.in[3];
    float* PARTO = (float*)(F.ws + WS_PARTO); float* PARTL = (float*)(F.ws + WS_PARTL);
    int lane = F.lane; asm volatile("" : "+v"(lane)); const int w = F.wave, r = lane & 31, hh = lane >> 5, m = w >> 2, eb = w & 3;
    bf16x8 qf[4];
#pragma unroll
    for (int d0 = 0; d0 < 4; ++d0) qf[d0] = *(const bf16x8*)(Qb + (size_t)(MP + b * DSEQ + r) * DM + h * 128 + m * 64 + 16 * d0 + 8 * hh);
    f32x16 O;
#pragma unroll
    for (int i = 0; i < 16; ++i) O[i] = 0.f;
    float l = 0.f;
    int tid_ = F.tid; asm volatile("" : "+v"(tid_)); const int pr0 = tid_ >> 4, pc = tid_ & 15;
    const int so0 = tile_off(pr0, pc), so1 = tile_off(pr0 + 32, pc);
    const size_t pos0 = (size_t)sp * 2048;
    const float* kg = ck + (((size_t)b * PAST + pos0 + pr0) * NH + h) * 128 + pc * 8; const float* vg = cv + (((size_t)b * PAST + pos0 + pr0) * NH + h) * 128 + pc * 8;
    constexpr size_t RS = (size_t)NH * 128;
    constexpr int NTC = 32;
    const int NT = NTC + (sp == 1 ? 1 : 0);
    f32x4 sk[4], sv[4];
#define LOADC(t) do { const size_t o_ = (size_t)(t) * 64 * RS; sk[0] = *(const f32x4*)(kg + o_); sk[1] = *(const f32x4*)(kg + o_ + 4); sk[2] = *(const f32x4*)(kg + o_ + 32 * RS); sk[3] = *(const f32x4*)(kg + o_ + 32 * RS + 4); \
        sv[0] = *(const f32x4*)(vg + o_); sv[1] = *(const f32x4*)(vg + o_ + 4); sv[2] = *(const f32x4*)(vg + o_ + 32 * RS); sv[3] = *(const f32x4*)(vg + o_ + 32 * RS + 4); } while (0)
#define PK8(a, b_) ((u32x4){pk2((a).x, (a).y), pk2((a).z, (a).w), pk2((b_).x, (b_).y), pk2((b_).z, (b_).w)})
#define STOREC(buf) do { LAS unsigned char* K_ = F.lds + (buf) * 32768; LAS unsigned char* V_ = K_ + 16384; \
        *(LAS u32x4*)(K_ + so0) = PK8(sk[0], sk[1]); *(LAS u32x4*)(K_ + so1) = PK8(sk[2], sk[3]); *(LAS u32x4*)(V_ + so0) = PK8(sv[0], sv[1]); *(LAS u32x4*)(V_ + so1) = PK8(sv[2], sv[3]); } while (0)
    LOADC(0);
    __syncthreads();
    STOREC(0);
    __syncthreads();
    for (int t = 0; t < NT; ++t) {
        const bool more_c = t + 1 < NTC, more_n = (t + 1 == NTC) && (sp == 1);
        u32x4 nk, nv;
        if (more_c) LOADC(t + 1);
        if (more_n) { nk = *(const u32x4*)(Kb + (size_t)(MP + b * DSEQ + pr0) * DM + h * 128 + pc * 8); nv = *(const u32x4*)(Vb + (size_t)(MP + b * DSEQ + pr0) * DM + h * 128 + pc * 8); }
        const LAS unsigned char* KT = F.lds + (t & 1) * 32768; const LAS unsigned char* VT = KT + 16384;
        const int nkb = t < NTC ? 2 : 1;
        {
            f32x16 s0 = qk_block(KT, 0, m, qf, r, hh);
            l += exp_block(s0);
            O = __builtin_amdgcn_mfma_f32_32x32x16_bf16(vfrag(VT, eb, 0, 0, lane), pfrag(s0, 0), O, 0, 0, 0);
            O = __builtin_amdgcn_mfma_f32_32x32x16_bf16(vfrag(VT, eb, 0, 1, lane), pfrag(s0, 1), O, 0, 0, 0);
            if (nkb == 2) {
                f32x16 s1 = qk_block(KT, 1, m, qf, r, hh);
                l += exp_block(s1);
                O = __builtin_amdgcn_mfma_f32_32x32x16_bf16(vfrag(VT, eb, 1, 0, lane), pfrag(s1, 0), O, 0, 0, 0);
                O = __builtin_amdgcn_mfma_f32_32x32x16_bf16(vfrag(VT, eb, 1, 1, lane), pfrag(s1, 1), O, 0, 0, 0);
            }
        }
        if (more_c) STOREC((t + 1) & 1);
        if (more_n) { LAS unsigned char* K_ = F.lds + ((t + 1) & 1) * 32768; LAS unsigned char* V_ = K_ + 16384; *(LAS u32x4*)(K_ + so0) = nk; *(LAS u32x4*)(V_ + so0) = nv; }
        __syncthreads();
    }
#undef LOADC
#undef PK8
#undef STOREC
    l += __shfl_xor(l, 32);
    const size_t pidx = (((size_t)(b * NH + h) * 2 + sp) * 2 + m);
    float* po = PARTO + pidx * 4096;
#pragma unroll
    for (int i = 0; i < 16; ++i) { const int e = 32 * eb + (i & 3) + 8 * (i >> 2) + 4 * hh; po[e * 32 + r] = O[i]; }
    if (eb == 0 && hh == 0) PARTL[pidx * 32 + r] = l;
}

__device__ __forceinline__ void attn_sample_combine(const Frame& F, int b, int h, float lam) {
    const float* PARTO = (const float*)(F.ws + WS_PARTO); const float* PARTL = (const float*)(F.ws + WS_PARTL); bf16* OA = (bf16*)(F.ws + WS_OAB); const float* subw = F.in[14];
    LAS float* red = (LAS float*)F.lds;
    int tid_ = F.tid; asm volatile("" : "+v"(tid_)); const int q = tid_ & 31, eg = tid_ >> 5, e0 = eg * 8;
    const size_t p00 = ((size_t)(b * NH + h) * 2 + 0) * 2, p10 = ((size_t)(b * NH + h) * 2 + 1) * 2;
    const float l0 = PARTL[(p00 + 0) * 32 + q] + PARTL[(p10 + 0) * 32 + q], l1 = PARTL[(p00 + 1) * 32 + q] + PARTL[(p10 + 1) * 32 + q];
    const float i0 = 1.f / l0, i1 = lam / l1;
    float o[8]; float ss = 0.f;
#pragma unroll
    for (int i = 0; i < 8; ++i) { const int e = e0 + i;
        const float a = PARTO[(p00 + 0) * 4096 + e * 32 + q] + PARTO[(p10 + 0) * 4096 + e * 32 + q], c = PARTO[(p00 + 1) * 4096 + e * 32 + q] + PARTO[(p10 + 1) * 4096 + e * 32 + q];
        o[i] = a * i0 - c * i1; ss += o[i] * o[i]; }
    __syncthreads();
    red[q * 16 + eg] = ss;
    __syncthreads();
    float tot = 0.f;
#pragma unroll
    for (int i = 0; i < 16; ++i) tot += red[q * 16 + i];
    const float rs = rsqrtf(tot * (1.f / 128.f) + EPS) * (1.f - LAM_INIT);
    const f32x4 s0 = *(const f32x4*)(subw + e0), s1 = *(const f32x4*)(subw + e0 + 4);
    u32x4 ov; ov.x = pk2(o[0] * rs * s0.x, o[1] * rs * s0.y); ov.y = pk2(o[2] * rs * s0.z, o[3] * rs * s0.w); ov.z = pk2(o[4] * rs * s1.x, o[5] * rs * s1.y); ov.w = pk2(o[6] * rs * s1.z, o[7] * rs * s1.w);
    *(u32x4*)(OA + (size_t)(MP + b * DSEQ + q) * DM + h * 128 + e0) = ov;
}

__device__ __forceinline__ void delta_seq_unit(const Frame& F, int seq, int h) {
    const bf16* QKVC = (const bf16*)(F.ws + WS_QKVC); const float* BETA = (const float*)(F.ws + WS_BETA); const float* GARR = (const float*)(F.ws + WS_G);
    const bf16* DG = (const bf16*)(F.ws + WS_DG); bf16* OB = (bf16*)(F.ws + WS_OAB) + (size_t)MT * DM; const float* dnw = F.in[19];
    const bool sample = seq >= NB; const int L = sample ? DSEQ : SEQ; const size_t row0 = sample ? (size_t)MP + (size_t)(seq - NB) * DSEQ : (size_t)seq * SEQ;
    float* sout = F.out + (sample ? OFF_DS + ((size_t)(seq - NB) * NH + h) * 16384 : OFF_DP + ((size_t)seq * NH + h) * 16384);
    int tid = F.tid; asm volatile("" : "+v"(tid)); const int e = tid & 127, dq = tid >> 7;
    LAS float* Lq = (LAS float*)F.lds; LAS float* Lk = Lq + 4096; LAS float* Lv = Lk + 4096; LAS float* Lb = Lv + 4096; LAS float* Lg = Lb + 32; LAS float* Lqk = Lg + 32;
    LAS float* Lx = Lqk + 32; LAS float* Lo = Lx + 2048;
    float S[32];
    if (sample) { const float* s0 = F.in[4] + ((size_t)(seq - NB) * NH + h) * 16384;
#pragma unroll
        for (int i = 0; i < 32; ++i) S[i] = s0[(32 * dq + i) * 128 + e]; }
    else {
#pragma unroll
        for (int i = 0; i < 32; ++i) S[i] = 0.f; }
    for (int tb = 0; tb < L; tb += 32) {
        __syncthreads();
        { const int f = tid >> 4, c8 = (tid & 15) * 8; const bf16* src = QKVC + (row0 + tb + f) * CONVCH + h * 128 + c8;
#pragma unroll
          for (int part = 0; part < 3; ++part) { const u32x4 v = *(const u32x4*)(src + part * 1024); LAS float* d = (part == 0 ? Lq : part == 1 ? Lk : Lv) + f * 128 + c8;
              *(LAS f32x4*)d = (f32x4){bflo(v.x), bfhi(v.x), bflo(v.y), bfhi(v.y)}; *(LAS f32x4*)(d + 4) = (f32x4){bflo(v.z), bfhi(v.z), bflo(v.w), bfhi(v.w)}; }
          if (tid < 32) { Lb[tid] = BETA[(row0 + tb + tid) * 8 + h]; Lg[tid] = __expf(GARR[(row0 + tb + tid) * 8 + h]); } }
        __syncthreads();
        { const int f = tid >> 4, c8 = (tid & 15) * 8; float a = 0.f;
#pragma unroll
          for (int i = 0; i < 8; ++i) a += Lq[f * 128 + c8 + i] * Lk[f * 128 + c8 + i];
          a += __shfl_xor(a, 1); a += __shfl_xor(a, 2); a += __shfl_xor(a, 4); a += __shfl_xor(a, 8);
          if ((tid & 15) == 0) Lqk[f] = a; }
        __syncthreads();
        for (int f = 0; f < 32; ++f) {
            float pk = 0.f, pq = 0.f;
            const LAS f32x4* kp = (const LAS f32x4*)(Lk + f * 128 + 32 * dq); const LAS f32x4* qp = (const LAS f32x4*)(Lq + f * 128 + 32 * dq);
            float kr[32];
#pragma unroll
            for (int i4 = 0; i4 < 8; ++i4) { const f32x4 kv = kp[i4], qv = qp[i4];
                kr[4 * i4] = kv.x; kr[4 * i4 + 1] = kv.y; kr[4 * i4 + 2] = kv.z; kr[4 * i4 + 3] = kv.w;
                pk += kv.x * S[4 * i4] + kv.y * S[4 * i4 + 1] + kv.z * S[4 * i4 + 2] + kv.w * S[4 * i4 + 3];
                pq += qv.x * S[4 * i4] + qv.y * S[4 * i4 + 1] + qv.z * S[4 * i4 + 2] + qv.w * S[4 * i4 + 3]; }
            LAS float* X = Lx + (f & 1) * 1024;
            X[dq * 128 + e] = pk; X[512 + dq * 128 + e] = pq;
            __syncthreads();
            const float kS = (X[e] + X[128 + e]) + (X[256 + e] + X[384 + e]); const float qS = (X[512 + e] + X[640 + e]) + (X[768 + e] + X[896 + e]);
            const float eg = Lg[f], be = Lb[f];
            const float dl = be * (Lv[f * 128 + e] - eg * kS);
#pragma unroll
            for (int i = 0; i < 32; ++i) S[i] = eg * S[i] + kr[i] * dl;
            if (dq == 0) Lo[f * 128 + e] = eg * qS + Lqk[f] * dl;
        }
        __syncthreads();
        { const int w = F.wave, lane = F.lane;
#pragma unroll
          for (int ff = 0; ff < 4; ++ff) { const int f = 4 * w + ff; const float a = Lo[f * 128 + 2 * lane], c = Lo[f * 128 + 2 * lane + 1];
              const float ss = wave_sum(a * a + c * c); const float rs = rsqrtf(ss * (1.f / 128.f) + EPS);
              const unsigned gw_ = *(const unsigned*)(DG + (row0 + tb + f) * DM + h * 128 + 2 * lane); const float g0 = bflo(gw_), g1 = bfhi(gw_);
              const float o0 = a * rs * dnw[2 * lane] * (g0 * sigmoidf_(g0)), o1 = c * rs * dnw[2 * lane + 1] * (g1 * sigmoidf_(g1));
              *(unsigned*)(OB + (row0 + tb + f) * DM + h * 128 + 2 * lane) = pk2(o0, o1); } }
    }
#pragma unroll
    for (int i = 0; i < 32; ++i) sout[(32 * dq + i) * 128 + e] = S[i];
}

constexpr size_t WS_DW = 910 * MiB;
constexpr size_t WS_DAL = 976 * MiB;
constexpr size_t WS_DEG = 1009 * MiB;
constexpr size_t WS_DUT_P = 455 * MiB;
constexpr size_t WS_DUT_S = 1012 * MiB;
constexpr size_t WS_END2 = 1014 * MiB;
static_assert(WS_DUT_P >= WS_OAB + 130 * MiB && WS_DUT_P + 64 * MiB <= WS_QKVC && WS_DW >= WS_GB + 65 * MiB, "delta workspace map");
__device__ __forceinline__ bf16* dut_ptr(unsigned char* ws, size_t ch) { return (bf16*)(ws + (ch < 4096 ? WS_DUT_P + ch * 16384 : WS_DUT_S + (ch - 4096) * 16384)); }
constexpr int NCH = 528;


template <int I> struct SolveRow {
    static __device__ __forceinline__ void run(f32x2 (&x)[64], const f32x16 (&Mt)[3], float cf) {
        f32x2 a0 = {0.f, 0.f}, a1 = {0.f, 0.f}, a2 = {0.f, 0.f}, a3 = {0.f, 0.f};
        constexpr int q = (I & 3) + 4 * ((I >> 3) & 3), lh = 32 * ((I >> 2) & 1);
#pragma unroll
        for (int j = 0; j < I; ++j) {
            const int t3 = (I >> 5) == 0 ? 0 : ((j >> 5) == 0 ? 1 : 2);
            const float mv = Mt[t3][q]; const float m = __int_as_float(__builtin_amdgcn_readlane(__float_as_int(mv), (j & 31) + lh));
            if ((j & 3) == 0) a0 += m * x[j]; else if ((j & 3) == 1) a1 += m * x[j]; else if ((j & 3) == 2) a2 += m * x[j]; else a3 += m * x[j];
        }
        const float ci = __int_as_float(__builtin_amdgcn_readlane(__float_as_int(cf), I));
        x[I] = ci * x[I] - ((a0 + a1) + (a2 + a3));
        SolveRow<I + 1>::run(x, Mt, cf);
    }
};
template <> struct SolveRow<64> { static __device__ __forceinline__ void run(f32x2 (&)[64], const f32x16 (&)[3], float) {} };

__device__ __forceinline__ void delta_chunk_unit(const Frame& F, int cu) {
    bf16* DW = (bf16*)(F.ws + WS_DW); bf16* DAL = (bf16*)(F.ws + WS_DAL); float* DEG = (float*)(F.ws + WS_DEG);
    const bf16* QKVC = (const bf16*)(F.ws + WS_QKVC); const float* BETA = (const float*)(F.ws + WS_BETA); const float* GARR = (const float*)(F.ws + WS_G);
    int lane = F.lane; asm volatile("" : "+v"(lane)); const int h = F.wave, r = lane & 31, hh = lane >> 5;
    const bool sample = cu >= 512; const size_t row0 = sample ? (size_t)MP + (size_t)(cu - 512) * 32 : (size_t)cu * 64; const int nvalid = sample ? 32 : 64;
    const size_t ch = (size_t)cu * 8 + h;
    LAS float* tabG = (LAS float*)(F.lds + h * 1024); LAS float* tabB = tabG + 64;
    float gc = lane < nvalid ? GARR[(row0 + lane) * 8 + h] : 0.f; const float be = lane < nvalid ? BETA[(row0 + lane) * 8 + h] : 0.f;
#pragma unroll
    for (int o = 1; o < 64; o <<= 1) { const float t = __shfl_up(gc, o); if (lane >= o) gc += t; }
    const float glast = __shfl(gc, 63);
    tabG[lane] = gc; tabB[lane] = be;
    DEG[ch * 128 + lane] = __expf(gc); DEG[ch * 128 + 64 + lane] = __expf(glast - gc);
    bf16x8 kf[2][8];
#pragma unroll
    for (int ib = 0; ib < 2; ++ib)
#pragma unroll
        for (int d0 = 0; d0 < 8; ++d0) { if (sample && ib == 1) kf[ib][d0] = (bf16x8){0, 0, 0, 0, 0, 0, 0, 0}; else kf[ib][d0] = *(const bf16x8*)(QKVC + (row0 + 32 * ib + r) * CONVCH + 1024 + h * 128 + 16 * d0 + 8 * hh); }
    const float gj0 = __shfl(gc, r), gj1 = __shfl(gc, 32 + r);
    LDS_WAIT();
    f32x16 Mt[3];
#pragma unroll
    for (int t3 = 0; t3 < 3; ++t3) { const int ib = t3 == 0 ? 0 : 1, jb = t3 == 2 ? 1 : 0;
        f32x16 acc;
#pragma unroll
        for (int i = 0; i < 16; ++i) acc[i] = 0.f;
#pragma unroll
        for (int d0 = 0; d0 < 8; ++d0) acc = __builtin_amdgcn_mfma_f32_32x32x16_bf16(kf[ib][d0], kf[jb][d0], acc, 0, 0, 0);
        const float gj = jb ? gj1 : gj0;
#pragma unroll
        for (int q = 0; q < 16; ++q) { const int i = 32 * ib + (q & 3) + 8 * (q >> 2) + 4 * hh; const float d = fminf(tabG[i] - gj, 0.f);
            Mt[t3][q] = tabB[i] * acc[q] * __expf(d); }
    }
#pragma unroll
    for (int ib = 0; ib < 2; ++ib) {
        bf16x8 qf[8];
#pragma unroll
        for (int d0 = 0; d0 < 8; ++d0) { if (sample && ib == 1) qf[d0] = (bf16x8){0, 0, 0, 0, 0, 0, 0, 0}; else qf[d0] = *(const bf16x8*)(QKVC + (row0 + 32 * ib + r) * CONVCH + h * 128 + 16 * d0 + 8 * hh); }
#pragma unroll
        for (int jb = 0; jb <= ib; ++jb) {
            f32x16 acc;
#pragma unroll
            for (int i = 0; i < 16; ++i) acc[i] = 0.f;
#pragma unroll
            for (int d0 = 0; d0 < 8; ++d0) acc = __builtin_amdgcn_mfma_f32_32x32x16_bf16(qf[d0], kf[jb][d0], acc, 0, 0, 0);
            const float gj = jb ? gj1 : gj0; const int j = 32 * jb + r;
            bf16* ad = DAL + ch * 4096 + j; asm volatile("" : "+v"(ad));
#pragma unroll
            for (int q = 0; q < 16; ++q) { const int i = 32 * ib + (q & 3) + 8 * (q >> 2) + 4 * hh; const float d = fminf(tabG[i] - gj, 0.f);
                const float a = i >= j ? acc[q] * __expf(d) : 0.f;
                ad[i * 64] = (bf16)(pk2(a, 0.f) & 0xffffu); }
            asm volatile("" ::: "memory");
        }
    }
    const float cu_ = be, cw_ = be * __expf(gc);
#pragma unroll 1
    for (int p = 0; p < 2; ++p) {
        const bool isw = p == 1;
        const bf16* src = QKVC + row0 * CONVCH + (isw ? 1024 : 2048) + h * 128 + lane; asm volatile("" : "+v"(src));
        float cf = isw ? cw_ : cu_; asm volatile("" : "+v"(cf));
        f32x2 x[64];
#pragma unroll
        for (int i = 0; i < 64; ++i) { const int ic = (sample && i >= 32) ? 31 : i; x[i].x = bf1(src[(size_t)ic * CONVCH]); x[i].y = bf1(src[(size_t)ic * CONVCH + 64]); if ((i & 7) == 7) asm volatile("" ::: "memory"); }
        SolveRow<0>::run(x, Mt, cf);
        if (!isw) { bf16* d0_ = dut_ptr(F.ws, ch) + (size_t)lane * 64; asm volatile("" : "+v"(d0_)); bf16* d1_ = d0_ + 64 * 64;
#pragma unroll
            for (int i8 = 0; i8 < 8; ++i8) { u32x4 o; o.x = pk2(x[8 * i8].x, x[8 * i8 + 1].x); o.y = pk2(x[8 * i8 + 2].x, x[8 * i8 + 3].x); o.z = pk2(x[8 * i8 + 4].x, x[8 * i8 + 5].x); o.w = pk2(x[8 * i8 + 6].x, x[8 * i8 + 7].x); *(u32x4*)(d0_ + 8 * i8) = o;
                o.x = pk2(x[8 * i8].y, x[8 * i8 + 1].y); o.y = pk2(x[8 * i8 + 2].y, x[8 * i8 + 3].y); o.z = pk2(x[8 * i8 + 4].y, x[8 * i8 + 5].y); o.w = pk2(x[8 * i8 + 6].y, x[8 * i8 + 7].y); *(u32x4*)(d1_ + 8 * i8) = o; } }
        else { bf16* dst = DW + ch * 8192 + lane; asm volatile("" : "+v"(dst));
#pragma unroll
            for (int i = 0; i < 64; ++i) { dst[i * 128] = (bf16)(pk2(x[i].x, 0.f) & 0xffffu); dst[i * 128 + 64] = (bf16)(pk2(x[i].y, 0.f) & 0xffffu); if ((i & 7) == 7) asm volatile("" ::: "memory"); } }
    }
}

__device__ __forceinline__ int vt_off(int e, int chunk) { return 128 * e + 16 * (chunk ^ ((e >> 1) & 7)); }
__device__ __forceinline__ void delta_scan_unit(const Frame& F, int seq, int h) {
    const bf16* DW = (const bf16*)(F.ws + WS_DW); const bf16* DAL = (const bf16*)(F.ws + WS_DAL); const float* DEG = (const float*)(F.ws + WS_DEG);
    const bf16* QKVC = (const bf16*)(F.ws + WS_QKVC); const bf16* DG = (const bf16*)(F.ws + WS_DG); bf16* OB = (bf16*)(F.ws + WS_OAB) + (size_t)MT * DM; const float* dnw = F.in[19];
    int tid = F.tid; asm volatile("" : "+v"(tid)); const int lane = tid & 63, w = F.wave, r = lane & 31, hh = lane >> 5;
    const bool sample = seq >= NB; const int nsteps = sample ? 1 : 32; const int nvalid = sample ? 32 : 64;
    const size_t rowbase = sample ? (size_t)MP + (size_t)(seq - NB) * DSEQ : (size_t)seq * SEQ;
    const size_t ch0 = sample ? (size_t)(512 + (seq - NB)) * 8 + h : (size_t)(seq * 32) * 8 + h;
    float* sout = F.out + (sample ? OFF_DS + ((size_t)(seq - NB) * NH + h) * 16384 : OFF_DP + ((size_t)seq * NH + h) * 16384);
    LAS unsigned char* ST = F.lds; LAS unsigned char* VT = F.lds + 32768; LAS unsigned char* VTP = F.lds + 49152; LAS unsigned char* KI = F.lds + 65536;
    LAS float* Ost = (LAS float*)(F.lds + 98304); LAS float* tab0 = (LAS float*)(F.lds + 131072);
    const int ib = w & 1, ebp = w >> 1, dkb = w >> 1, eb0 = 2 * (w & 1);
    f32x16 S[2];
    if (sample) { const float* s0 = F.in[4] + ((size_t)(seq - NB) * NH + h) * 16384;
#pragma unroll
        for (int t = 0; t < 2; ++t)
#pragma unroll
            for (int q = 0; q < 16; ++q) S[t][q] = s0[(size_t)(32 * dkb + (q & 3) + 8 * (q >> 2) + 4 * hh) * 128 + 32 * (eb0 + t) + r]; }
    else {
#pragma unroll
        for (int t = 0; t < 2; ++t)
#pragma unroll
            for (int q = 0; q < 16; ++q) S[t][q] = 0.f; }
    __syncthreads();
#define WRITE_ST() do { _Pragma("unroll") for (int t_ = 0; t_ < 2; ++t_) { const int e_ = 32 * (eb0 + t_) + r; _Pragma("unroll") for (int g4 = 0; g4 < 4; ++g4) { \
        u32x2 o_; o_.x = pk2(S[t_][4 * g4], S[t_][4 * g4 + 1]); o_.y = pk2(S[t_][4 * g4 + 2], S[t_][4 * g4 + 3]); \
        *(LAS u32x2*)(ST + tile_off(e_, 4 * dkb + g4) + 8 * hh) = o_; } } } while (0)
    WRITE_ST();
    const int pr0 = tid >> 4, pc = tid & 15; const int so0 = tile_off(pr0, pc), so1 = tile_off(pr0 + 32, pc);
    const bf16* kbase = QKVC + (rowbase + pr0) * CONVCH + 1024 + h * 128 + pc * 8;
    u32x4 kst[2];
    kst[0] = *(const u32x4*)kbase; kst[1] = (sample) ? (u32x4){0u, 0u, 0u, 0u} : *(const u32x4*)(kbase + (size_t)32 * CONVCH);
    *(LAS u32x4*)(KI + so0) = kst[0]; *(LAS u32x4*)(KI + so1) = kst[1];
    int vb[1][2];
    { const int gsel = (lane >> 4) & 1, q = (lane >> 2) & 3, p = lane & 3;
#pragma unroll
      for (int hl = 0; hl < 2; ++hl) { const int row = 4 * hh + q + 8 * hl; vb[0][hl] = 256 * row + 16 * ((4 * dkb + 2 * gsel + (p >> 1)) ^ swz_f(row)) + 8 * (p & 1); } }
    const int e1 = 32 * ebp + r;
    const int st_row = 256 * e1, st_fz = swz_f(e1) ^ hh;
    for (int n = 0; n < nsteps; ++n) {
        const size_t ch = ch0 + 8 * (size_t)n; const size_t rown = rowbase + (size_t)n * 64;
        bf16x8 wf[8], qf[8];
        { const bool zr = sample && ib == 1;
#pragma unroll
          for (int d0 = 0; d0 < 8; ++d0) { wf[d0] = *(const bf16x8*)(DW + ch * 8192 + (size_t)(32 * ib + r) * 128 + 16 * d0 + 8 * hh);
              qf[d0] = zr ? (bf16x8){0, 0, 0, 0, 0, 0, 0, 0} : *(const bf16x8*)(QKVC + (rown + 32 * ib + r) * CONVCH + h * 128 + 16 * d0 + 8 * hh); } }
        LAS float* tabEG = tab0 + (n & 1) * 128; LAS float* tabET = tabEG + 64;
        if (tid < 128) tabEG[tid] = DEG[ch * 128 + tid];
        const bool more = n + 1 < nsteps;
        if (more) { const bf16* kn = kbase + (size_t)(n + 1) * 64 * CONVCH; kst[0] = *(const u32x4*)kn; kst[1] = *(const u32x4*)(kn + (size_t)32 * CONVCH); }
        __syncthreads();
        if (n > 0) {
            const size_t rowp = rown - 64;
#pragma unroll
            for (int ff = 0; ff < 8; ++ff) { const int f = 8 * w + ff; const float a = Ost[f * 128 + 2 * lane], c = Ost[f * 128 + 2 * lane + 1];
                const float ss = wave_sum(a * a + c * c); const float rs = rsqrtf(ss * (1.f / 128.f) + EPS);
                const unsigned gw_ = *(const unsigned*)(DG + (rowp + f) * DM + h * 128 + 2 * lane); const float g0 = bflo(gw_), g1 = bfhi(gw_);
                *(unsigned*)(OB + (rowp + f) * DM + h * 128 + 2 * lane) = pk2(a * rs * dnw[2 * lane] * (g0 * sigmoidf_(g0)), c * rs * dnw[2 * lane + 1] * (g1 * sigmoidf_(g1))); }
        }
        f32x16 ws_, qs_;
#pragma unroll
        for (int q = 0; q < 16; ++q) { ws_[q] = 0.f; qs_[q] = 0.f; }
#pragma unroll
        for (int d0 = 0; d0 < 8; ++d0) { const bf16x8 sf = *(const LAS bf16x8*)(ST + st_row + 16 * ((2 * d0) ^ st_fz));
            ws_ = __builtin_amdgcn_mfma_f32_32x32x16_bf16(wf[d0], sf, ws_, 0, 0, 0); qs_ = __builtin_amdgcn_mfma_f32_32x32x16_bf16(qf[d0], sf, qs_, 0, 0, 0); }
        { const bf16* up = dut_ptr(F.ws, ch) + (size_t)e1 * 64 + 32 * ib + 4 * hh;
#pragma unroll
          for (int g4 = 0; g4 < 4; ++g4) { const u32x2 uu = *(const u32x2*)(up + 8 * g4); const int i0 = 32 * ib + 8 * g4 + 4 * hh;
              const float v0 = bflo(uu.x) - ws_[4 * g4], v1 = bfhi(uu.x) - ws_[4 * g4 + 1], v2 = bflo(uu.y) - ws_[4 * g4 + 2], v3 = bfhi(uu.y) - ws_[4 * g4 + 3];
              const f32x4 et = *(const LAS f32x4*)(tabET + i0), eg = *(const LAS f32x4*)(tabEG + i0);
              u32x2 a, b; a.x = pk2(v0, v1); a.y = pk2(v2, v3); b.x = pk2(v0 * et.x, v1 * et.y); b.y = pk2(v2 * et.z, v3 * et.w);
              const int off = vt_off(e1, 4 * ib + g4) + 8 * hh;
              *(LAS u32x2*)(VT + off) = a; *(LAS u32x2*)(VTP + off) = b;
              qs_[4 * g4] *= eg.x; qs_[4 * g4 + 1] *= eg.y; qs_[4 * g4 + 2] *= eg.z; qs_[4 * g4 + 3] *= eg.w; } }
        if (more) { LAS unsigned char* KN = KI + ((n + 1) & 1) * 16384; *(LAS u32x4*)(KN + so0) = kst[0]; *(LAS u32x4*)(KN + so1) = kst[1]; }
        __syncthreads();
#pragma unroll
        for (int jb = 0; jb < 2; ++jb) { if (jb <= ib) {
#pragma unroll
            for (int s = 0; s < 2; ++s) { const bf16x8 af = *(const bf16x8*)(DAL + ch * 4096 + (size_t)(32 * ib + r) * 64 + 32 * jb + 16 * s + 8 * hh);
                const bf16x8 vf = *(const LAS bf16x8*)(VT + vt_off(e1, 4 * jb + 2 * s + hh));
                qs_ = __builtin_amdgcn_mfma_f32_32x32x16_bf16(af, vf, qs_, 0, 0, 0); } } }
#pragma unroll
        for (int q = 0; q < 16; ++q) Ost[(32 * ib + (q & 3) + 8 * (q >> 2) + 4 * hh) * 128 + e1] = qs_[q];
        { const float gt = tabEG[63]; const LAS unsigned char* KC = KI + (n & 1) * 16384;
#pragma unroll
          for (int t = 0; t < 2; ++t) { const int e = 32 * (eb0 + t) + r;
#pragma unroll
              for (int q = 0; q < 16; ++q) S[t][q] *= gt;
#pragma unroll
              for (int kb = 0; kb < 2; ++kb)
#pragma unroll
                  for (int s = 0; s < 2; ++s) {
                      const s16x4 lo = vtr(KC + vb[0][0] + 8192 * kb + 4096 * s), hi = vtr(KC + vb[0][1] + 8192 * kb + 4096 * s);
                      const u32x2 b0 = *(const LAS u32x2*)(VTP + vt_off(e, 4 * kb + 2 * s) + 8 * hh), b1 = *(const LAS u32x2*)(VTP + vt_off(e, 4 * kb + 2 * s + 1) + 8 * hh);
                      const u32x4 bb = {b0.x, b0.y, b1.x, b1.y};
                      S[t] = __builtin_amdgcn_mfma_f32_32x32x16_bf16((bf16x8){lo[0], lo[1], lo[2], lo[3], hi[0], hi[1], hi[2], hi[3]}, __builtin_bit_cast(bf16x8, bb), S[t], 0, 0, 0); } } }
        WRITE_ST();
    }
#undef WRITE_ST
    __syncthreads();
    { const size_t rowp = rowbase + (size_t)(nsteps - 1) * 64;
#pragma unroll
      for (int ff = 0; ff < 8; ++ff) { const int f = 8 * w + ff; if (f < nvalid) { const float a = Ost[f * 128 + 2 * lane], c = Ost[f * 128 + 2 * lane + 1];
          const float ss = wave_sum(a * a + c * c); const float rs = rsqrtf(ss * (1.f / 128.f) + EPS);
          const unsigned gw_ = *(const unsigned*)(DG + (rowp + f) * DM + h * 128 + 2 * lane); const float g0 = bflo(gw_), g1 = bfhi(gw_);
          *(unsigned*)(OB + (rowp + f) * DM + h * 128 + 2 * lane) = pk2(a * rs * dnw[2 * lane] * (g0 * sigmoidf_(g0)), c * rs * dnw[2 * lane + 1] * (g1 * sigmoidf_(g1))); } } }
#pragma unroll
    for (int t = 0; t < 2; ++t)
#pragma unroll
        for (int q = 0; q < 16; ++q) sout[(size_t)(32 * dkb + (q & 3) + 8 * (q >> 2) + 4 * hh) * 128 + 32 * (eb0 + t) + r] = S[t][q];
}
#define LAS_ LAS
#define XB_TMO      128
#define XB_XCNT(j)  (256  + 64 * (j))
#define XB_XSUB(j)  (1280 + 64 * (j))
#define XB_XGEN(j)  (2304 + 64 * (j))
#define XB_TOP      3328
#define XB_TOPGEN   3392
#define XCD_BAR_WORDS 3456
#define XB_SPIN_CAP (1u << 18)

__device__ __forceinline__ unsigned xb_ld(unsigned* p)              { return __hip_atomic_load(p, __ATOMIC_RELAXED, __HIP_MEMORY_SCOPE_AGENT); }
__device__ __forceinline__ unsigned xb_add(unsigned* p, unsigned v) { return __hip_atomic_fetch_add(p, v, __ATOMIC_RELAXED, __HIP_MEMORY_SCOPE_AGENT); }
__device__ __forceinline__ unsigned xb_xcc_id() { return (unsigned)__builtin_amdgcn_s_getreg((3 << 11) | 20) & 0xFu; }
#define XB_SPIN(cond, bar) do { unsigned _sp = 0; while (cond) { __builtin_amdgcn_s_sleep(1); \
    if ((++_sp & 255u) == 0u) { if (xb_ld(&(bar)[XB_TMO])) break; if (_sp > XB_SPIN_CAP) { atomicAdd(&(bar)[XB_TMO], 1u); break; } } } } while (0)

struct XcdBarrier {
    unsigned* bar; unsigned x; int wave;
    volatile LAS unsigned* st;
};

__device__ __forceinline__ bool xb_leader(int wave) { return wave == 0 && fresh_lane_id() == 0; }
__device__ __forceinline__ XcdBarrier xcd_barrier_post(unsigned* bar, volatile LAS unsigned* st, int wave) {
    XcdBarrier b; b.bar = bar; b.x = xb_xcc_id(); b.st = st; b.wave = wave;
    if (xb_leader(wave)) (void)xb_add(&bar[XB_XCNT(b.x)], 1u);
    return b;
}
__device__ __forceinline__ void xcd_barrier_complete(unsigned* bar, unsigned x, unsigned& nloc, unsigned& nx) {
    const unsigned G = gridDim.x * gridDim.y * gridDim.z;
    unsigned sum, cnt, mine, sp = 0u;
    for (;;) {
        sum = 0u; cnt = 0u; mine = 0u;
#pragma unroll
        for (unsigned j = 0; j < 16; ++j) { const unsigned c = xb_ld(&bar[XB_XCNT(j)]); sum += c; cnt += (c > 0u) ? 1u : 0u; mine = (j == x) ? c : mine; }
        if (sum == G) break;
        __builtin_amdgcn_s_sleep(1);
        if ((++sp & 255u) == 0u) { if (xb_ld(&bar[XB_TMO])) break; if (sp > XB_SPIN_CAP) { atomicAdd(&bar[XB_TMO], 1u); break; } }
    }
    nloc = mine > 0u ? mine : 1u; nx = cnt > 0u ? cnt : 1u;
}

__device__ __forceinline__ void xcd_barrier(const XcdBarrier& b) {
    asm volatile("s_waitcnt vmcnt(0)" ::: "memory");
    __syncthreads();
    if (xb_leader(b.wave)) {
        unsigned* bar = b.bar;
        __builtin_amdgcn_s_waitcnt(0);
        unsigned nloc = b.st[0], nx = b.st[1];
        if (nloc == 0u) { xcd_barrier_complete(bar, b.x, nloc, nx); b.st[0] = nloc; b.st[1] = nx; }
        const unsigned old = xb_add(&bar[XB_XSUB(b.x)], 1u);
        const unsigned gen = old / nloc;
        if (old + 1u == (gen + 1u) * nloc) {
            __builtin_amdgcn_fence(__ATOMIC_RELEASE, "agent");
            asm volatile("s_waitcnt vmcnt(0)" ::: "memory");
            const unsigned og = xb_add(&bar[XB_TOP], 1u);
            const unsigned tg = og / nx;
            if (og + 1u == (tg + 1u) * nx) xb_add(&bar[XB_TOPGEN], 1u);
            else XB_SPIN(xb_ld(&bar[XB_TOPGEN]) == tg, bar);
            __builtin_amdgcn_fence(__ATOMIC_ACQUIRE, "agent");
            xb_add(&bar[XB_XGEN(b.x)], 1u);
            asm volatile("s_waitcnt vmcnt(0)" ::: "memory");
        } else {
            XB_SPIN(xb_ld(&bar[XB_XGEN(b.x)]) == gen, bar);
            __builtin_amdgcn_fence(__ATOMIC_ACQUIRE, "agent");
            asm volatile("s_waitcnt vmcnt(0)" ::: "memory");
        }
    }
    __syncthreads();
}

#ifndef PROBE_DUP
#define PROBE_DUP -1
#endif
#ifndef USE_XCDBAR
#define USE_XCDBAR 1
#endif
constexpr int CW_BAR = 1024, CW_Q4 = 192;
constexpr int N_PHASES = 9;
__device__ __forceinline__ int next_unit(const Frame& F, unsigned* ctr) {
    volatile LAS int* slot = (volatile LAS int*)(F.lds + LDS_BYTES - 16);
    __syncthreads();
    if (F.tid == 0) *slot = (int)__hip_atomic_fetch_add(ctr, 1u, __ATOMIC_RELAXED, __HIP_MEMORY_SCOPE_AGENT);
    __syncthreads();
    return *slot;
}

template <int PH> __device__ __forceinline__ void run_phase(const Frame& F0, int rep = 0) {
    Frame F = F0; F.lane = fresh_lane_id(); asm volatile("" : "+v"(F.lane)); F.tid = F.wave * 64 + F.lane;
    unsigned char* ws = F.ws;
    if constexpr (PH == 0) { p0_prologue(F); }
    if constexpr (PH == 1) {
        pg8::Gemm g{(const bf16*)(ws + WS_XN), (const bf16*)(ws + WS_WIN), MT, NZ, DM}; pg8::StaticOrder S; S.init(MT, NZ, F.G, F.bid);
        pg8::EpiZ E{ws, F.out};
        pg8::gemm_phase<pg8::EpiZ, pg8::StaticOrder, true, true>(F.lds, g, S, E, F.wave);
    }
    if constexpr (PH == 2) {
        unsigned* ctr = (unsigned*)(ws + WS_CTL) + CW_Q2 + 16 * rep;
        for (;;) { const int u = next_unit(F, ctr); if (u >= 256 + 780) break;
            if (u < 256) attn_sample_unit(F, u >> 4, (u >> 1) & 7, u & 1);
            else conv_task(F, (u - 256) * 8 + F.wave); }
    }
    if constexpr (PH == 3) {
        unsigned* ctr = (unsigned*)(ws + WS_CTL) + CW_Q3 + 16 * rep;
        for (;;) { const int u = next_unit(F, ctr); if (u >= NCH) break; delta_chunk_unit(F, u); }
    }
    if constexpr (PH == 8) {
        unsigned* ctr = (unsigned*)(ws + WS_CTL) + CW_Q4 + 16 * rep;
        const float lam = lambda_of(F);
        for (;;) { const int u = next_unit(F, ctr); if (u >= 128 + 2048 + 128 + 128) break;
            if (u < 128) delta_scan_unit(F, u >> 3, u & 7);
            else if (u < 2176) { const int a = u - 128; attn_prompt_unit(F, a & 15, (a >> 4) & 7, 15 - (a >> 7), lam); }
            else if (u < 2304) { const int a = u - 2176; delta_scan_unit(F, NB + (a >> 3), a & 7); }
            else { const int a = u - 2304; attn_sample_combine(F, a >> 3, a & 7, lam); } }
    }
    if constexpr (PH == 4) {
        pg8::Gemm g{(const bf16*)(ws + WS_OAB), (const bf16*)(ws + WS_WAB), 2 * MT, 2048, DM}; pg8::PairOrder S{F.G, F.bid};
        pg8::EpiAB E{ws, F.out + OFF_Y};
        pg8::gemm_phase<pg8::EpiAB, pg8::PairOrder, true, true>(F.lds, g, S, E, F.wave);
    }
    if constexpr (PH == 5) {
        pg8::Gemm g{(const bf16*)(ws + WS_MERGED), (const bf16*)(ws + WS_WO), MT, DM, DM}; pg8::StaticOrder S; S.init(MT, DM, F.G, F.bid);
        pg8::EpiOut E{F.in[0], F.in[1], F.out + OFF_Y, (bf16*)(ws + WS_X1B), (float*)(ws + WS_RSS)};
        pg8::gemm_phase<pg8::EpiOut, pg8::StaticOrder, true, true>(F.lds, g, S, E, F.wave);
    }
    if constexpr (PH == 6) {
        pg8::Gemm g{(const bf16*)(ws + WS_X1B), (const bf16*)(ws + WS_WGU), MT, 2 * DFF, DM}; pg8::StaticOrder S; S.init(MT, 2 * DFF, F.G, F.bid);
        pg8::EpiGU E{(const float*)(ws + WS_RSS), (bf16*)(ws + WS_ACT)};
        pg8::gemm_phase<pg8::EpiGU, pg8::StaticOrder, true, true>(F.lds, g, S, E, F.wave);
    }
    if constexpr (PH == 7) {
        pg8::Gemm g{(const bf16*)(ws + WS_ACT), (const bf16*)(ws + WS_WD), MT, DM, DFF}; pg8::StaticOrder S; S.init(MT, DM, F.G, F.bid);
        pg8::EpiDown E{F.out + OFF_Y};
        pg8::gemm_phase<pg8::EpiDown, pg8::StaticOrder, true, true>(F.lds, g, S, E, F.wave);
    }
}

__device__ __forceinline__ Frame make_frame(const Args& a, unsigned char* lds) {
    Frame F; F.lds = (LAS unsigned char*)lds; F.ws = a.ws; F.out = a.out; F.in = a.in;
    F.wave = __builtin_amdgcn_readfirstlane((int)threadIdx.x >> 6); F.lane = fresh_lane_id(); F.tid = F.wave * 64 + F.lane; F.G = gridDim.x; F.bid = blockIdx.x;
    return F;
}

#if MEGA
__global__ void __launch_bounds__(NTHREADS, 2) mega_kernel(Args a) {
    extern __shared__ __attribute__((aligned(16))) unsigned char lds[];
    cg::grid_group grid = cg::this_grid();
    const Frame F = make_frame(a, lds);
#if USE_XCDBAR
    if (F.tid < 8) ((LAS unsigned*)(F.lds + LDS_BYTES - 64))[F.tid] = 0u;
    __syncthreads();
    XcdBarrier bar = xcd_barrier_post((unsigned*)(a.ws + WS_CTL) + CW_BAR, (volatile LAS unsigned*)(F.lds + LDS_BYTES - 64), F.wave);
#define SEAM() xcd_barrier(bar)
#else
#define SEAM() grid.sync()
#endif
#define PHASE(k) do { run_phase<k>(F); if (PROBE_DUP == k) { SEAM(); run_phase<k>(F, 1); } } while (0)
    PHASE(0); grid.sync();
    PHASE(1); SEAM();
    PHASE(2); SEAM();
    PHASE(3); SEAM();
    PHASE(8); SEAM();
    PHASE(4); SEAM();
    PHASE(5); SEAM();
    PHASE(6); SEAM();
    run_phase<7>(F);
#undef PHASE
#undef SEAM
}
#else
template <int PH> __global__ void __launch_bounds__(NTHREADS, 2) phase_kernel(Args a) {
    extern __shared__ __attribute__((aligned(16))) unsigned char lds[];
    const Frame F = make_frame(a, lds);
    run_phase<PH>(F);
}
#endif

extern "C" void kernel_launch(void* const* d_in, const int* in_sizes, int n_in, void* d_out, int out_size, void* d_ws, size_t ws_size, hipStream_t stream) {
    static int grid = 0;
    if (grid == 0) {
        if (n_in != 25 || out_size != (int)OUT_TOTAL || ws_size < WS_END2) { fprintf(stderr, "kernel_launch: unexpected shapes n_in %d out %d ws %zu\n", n_in, out_size, ws_size); grid = -1; return; }
        int dev = 0, cus = 0;
        hipGetDevice(&dev); hipDeviceGetAttribute(&cus, hipDeviceAttributeMultiprocessorCount, dev);
#if MEGA
        hipFuncSetAttribute((const void*)mega_kernel, hipFuncAttributeMaxDynamicSharedMemorySize, LDS_BYTES);
        int per_cu = 0; hipOccupancyMaxActiveBlocksPerMultiprocessor(&per_cu, (const void*)mega_kernel, NTHREADS, LDS_BYTES);
        if (per_cu < 1) { fprintf(stderr, "kernel_launch: occupancy query says %d blocks per CU\n", per_cu); per_cu = 1; }
#else
        hipFuncSetAttribute((const void*)phase_kernel<0>, hipFuncAttributeMaxDynamicSharedMemorySize, LDS_BYTES);
        hipFuncSetAttribute((const void*)phase_kernel<1>, hipFuncAttributeMaxDynamicSharedMemorySize, LDS_BYTES);
        hipFuncSetAttribute((const void*)phase_kernel<2>, hipFuncAttributeMaxDynamicSharedMemorySize, LDS_BYTES);
        hipFuncSetAttribute((const void*)phase_kernel<3>, hipFuncAttributeMaxDynamicSharedMemorySize, LDS_BYTES);
        hipFuncSetAttribute((const void*)phase_kernel<4>, hipFuncAttributeMaxDynamicSharedMemorySize, LDS_BYTES);
        hipFuncSetAttribute((const void*)phase_kernel<5>, hipFuncAttributeMaxDynamicSharedMemorySize, LDS_BYTES);
        hipFuncSetAttribute((const void*)phase_kernel<6>, hipFuncAttributeMaxDynamicSharedMemorySize, LDS_BYTES);
        hipFuncSetAttribute((const void*)phase_kernel<7>, hipFuncAttributeMaxDynamicSharedMemorySize, LDS_BYTES);
#endif
        (void)hipGetLastError();
        grid = cus > 0 ? cus : 256;
    }
    if (grid < 0) return;
    hipMemsetAsync((char*)d_ws + WS_CTL, 0, CTL_ZERO_BYTES, stream);
    Args a{};
    for (int i = 0; i < 25; ++i) a.in[i] = (const float*)d_in[i];
    a.out = (float*)d_out; a.ws = (unsigned char*)d_ws; a.ph_lo = 0; a.ph_hi = N_PHASES;
#if MEGA
    void* args[] = {&a};
    hipError_t e = hipLaunchCooperativeKernel((const void*)mega_kernel, dim3(grid), dim3(NTHREADS), args, LDS_BYTES, stream);
    if (e != hipSuccess) fprintf(stderr, "cooperative launch failed: %s (grid %d)\n", hipGetErrorString(e), grid);
#else
    hipLaunchKernelGGL(phase_kernel<0>, dim3(grid), dim3(NTHREADS), LDS_BYTES, stream, a);
    hipLaunchKernelGGL(phase_kernel<1>, dim3(grid), dim3(NTHREADS), LDS_BYTES, stream, a);
    hipLaunchKernelGGL(phase_kernel<2>, dim3(grid), dim3(NTHREADS), LDS_BYTES, stream, a);
    hipLaunchKernelGGL(phase_kernel<3>, dim3(grid), dim3(NTHREADS), LDS_BYTES, stream, a);
    hipLaunchKernelGGL(phase_kernel<4>, dim3(grid), dim3(NTHREADS), LDS_BYTES, stream, a);
    hipLaunchKernelGGL(phase_kernel<5>, dim3(grid), dim3(NTHREADS), LDS_BYTES, stream, a);
    hipLaunchKernelGGL(phase_kernel<6>, dim3(grid), dim3(NTHREADS), LDS_BYTES, stream, a);
    hipLaunchKernelGGL(phase_kernel<7>, dim3(grid), dim3(NTHREADS), LDS_BYTES, stream, a);
#endif
}
```

```cpp
#include <hip/hip_runtime.h>
#include <hip/hip_cooperative_groups.h>
#include <cstdio>
#include <cstdint>
namespace cg = cooperative_groups;

#define LAS __attribute__((address_space(3)))
#define GAS __attribute__((address_space(1)))
typedef float f32x2 __attribute__((ext_vector_type(2)));
typedef float f32x16 __attribute__((ext_vector_type(16)));
typedef unsigned u32x2 __attribute__((ext_vector_type(2)));
typedef short s16x4 __attribute__((ext_vector_type(4)));
typedef __bf16 bf16x2_t __attribute__((ext_vector_type(2)));

constexpr int DM = 1024, NB = 16, SEQ = 2048, DECB = 16, DSEQ = 32, PAST = 4096;
constexpr int MP = NB * SEQ, MS = DECB * DSEQ, MT = MP + MS;
constexpr int NH = 8, DIN = 9232, NZ = 9216, DFF = 2816, CONVCH = 3072;
constexpr float EPS = 1e-6f;
constexpr float LAM_INIT = 0.2f;
constexpr float QSCALE = 0.125f * 1.4426950408889634f;
constexpr size_t OFF_Y = 0;
constexpr size_t OFF_KP = (size_t)MT * DM;
constexpr size_t OFF_VP = OFF_KP + (size_t)MP * DM;
constexpr size_t OFF_DP = OFF_VP + (size_t)MP * DM;
constexpr size_t OFF_CP = OFF_DP + (size_t)NB * NH * 128 * 128;
constexpr size_t OFF_KS = OFF_CP + (size_t)NB * 3 * CONVCH;
constexpr size_t OFF_VS = OFF_KS + (size_t)MS * DM;
constexpr size_t OFF_DS = OFF_VS + (size_t)MS * DM;
constexpr size_t OFF_CS = OFF_DS + (size_t)DECB * NH * 128 * 128;
constexpr size_t OUT_TOTAL = OFF_CS + (size_t)DECB * 3 * CONVCH;
static_assert(OUT_TOTAL == 106725376ull, "output size");

__device__ __forceinline__ int fresh_lane_id() { unsigned z = 0u; asm volatile("" : "+s"(z)); return (int)__builtin_amdgcn_mbcnt_hi(~0u, __builtin_amdgcn_mbcnt_lo(~0u, z)); }
#define MEGA 1

namespace pg8 {
#define PG8_LAS __attribute__((address_space(3)))
typedef unsigned short bf16_t;
typedef short bf16x8 __attribute__((ext_vector_type(8)));
typedef float f32x4 __attribute__((ext_vector_type(4)));
typedef unsigned u32x4 __attribute__((ext_vector_type(4)));
constexpr int BM = 256, BK = 64, HALF = 128, HTB = HALF * BK * 2  , STAGE_BYTES = 8 * HTB, NXCD = 8, WGM = 8;

__host__ __device__ __forceinline__ int lds_byte(int r, int c) { const int st = (r >> 4) * 2 + (c >> 5), rr = r & 15, cc = c & 31, ob = rr * 64 + cc * 2; return st * 1024 + (ob ^ (((ob >> 9) & 1) << 5)); }
__host__ __device__ __forceinline__ void stage_rc(int b, int& R, int& C) { const int st = b / 1024, sb = b % 1024, swz = sb ^ (((sb >> 9) & 1) << 5); R = (st >> 1) * 16 + swz / 64; C = (st & 1) * 32 + (swz % 64) / 2; }
__host__ __device__ __forceinline__ int perm32(int rho) { const int n = rho >> 4, i = rho & 15; return 8 * (i >> 2) + 4 * n + (i & 3); }

struct Unit { int pm, pn; };
struct Gemm { const bf16_t* A; const bf16_t* Bt; int M, N, K; };

struct StaticOrder {
    int nM, nN, nwg, G, c;
    __host__ __device__ void init(int M, int N, int G_, int c_) { nM = M / BM; nN = N / BM; nwg = nM * nN; G = G_; c = c_; }
    __host__ __device__ bool next(int i, Unit& u) const {
        const long L = (long)i * G + c; if (L >= nwg) return false;
        int wgid = (int)L; { const int q = nwg / NXCD, r = nwg % NXCD, xcd = wgid % NXCD, off = wgid / NXCD; wgid = (xcd < r ? xcd * (q + 1) : r * (q + 1) + (xcd - r) * q) + off; }
        const int nig = WGM * nN, gid = wgid / nig, fm = gid * WGM, gsz = (nM - fm) < WGM ? (nM - fm) : WGM;
        u.pm = fm + ((wgid % nig) % gsz); u.pn = (wgid % nig) / gsz; return true;
    }
    __device__ __forceinline__ void a_ready(const Unit&) const {}
    __device__ __forceinline__ void done(const Unit&) const {}
};

template <class Epi, class Sched, bool ALIGN_EPI = false, bool SP2 = false>
__device__ __forceinline__ void gemm_phase(PG8_LAS unsigned char* lds, const Gemm g, const Sched& S, const Epi& E, int wid_in) {
    int tid_ = wid_in * 64 + fresh_lane_id(); asm volatile("" : "+v"(tid_));
    const int tid = tid_, wid = __builtin_amdgcn_readfirstlane(tid >> 6), lane = tid & 63, wr = wid >> 2, wc = wid & 3, fr = lane & 15, fq = lane >> 4;
    const int K = g.K, nt = K / BK;
    unsigned voffA[2], voffB[2];
#pragma unroll
    for (int i = 0; i < 2; ++i) { int R, C; stage_rc(tid * 16 + i * 8192, R, C); const int Rb = Epi::PERM ? ((R & ~31) + perm32(R & 31)) : R;
        voffA[i] = (unsigned)(R * K + C) * 2u; voffB[i] = (unsigned)(Rb * K + C) * 2u; }
    const size_t kstep = (size_t)(BK * 2);
    const size_t hstep = (size_t)HALF * K * 2;
    const size_t tstep = 2 * hstep;
    const unsigned ldsw = (unsigned)wid * 1024u;
    const int aoff = lds_byte(wr * 64 + fr, fq * 8), boff = lds_byte(wc * 32 + fr, fq * 8);
#define PG8_SA(b, h) (((b) * 2 + (h)) * HTB)
#define PG8_SB(b, h) ((4 + (b) * 2 + (h)) * HTB)
#define PG8_STAGE(bufoff, gbase, voff) do { _Pragma("unroll") for (int _i = 0; _i < 2; ++_i) \
        __builtin_amdgcn_global_load_lds((const unsigned*)((const char*)(gbase) + (voff)[_i]), (PG8_LAS unsigned*)(lds + (bufoff) + ldsw + _i * 8192), 16, 0, 0); } while (0)
#define PG8_LDA(dst, b, h) do { _Pragma("unroll") for (int m = 0; m < 4; ++m) _Pragma("unroll") for (int k = 0; k < 2; ++k) dst[m][k] = *(const PG8_LAS bf16x8*)(lds + PG8_SA(b, h) + aoff + m * 2048 + k * 1024); } while (0)
#define PG8_LDB(dst, b, h) do { _Pragma("unroll") for (int n = 0; n < 2; ++n) _Pragma("unroll") for (int k = 0; k < 2; ++k) dst[n][k] = *(const PG8_LAS bf16x8*)(lds + PG8_SB(b, h) + boff + n * 2048 + k * 1024); } while (0)
#define PG8_MMA(ai, bj, At, Bt) do { __builtin_amdgcn_s_setprio(1); _Pragma("unroll") for (int m = 0; m < 4; ++m) _Pragma("unroll") for (int n = 0; n < 2; ++n) _Pragma("unroll") for (int k = 0; k < 2; ++k) \
        acc[ai][bj][m][n] = __builtin_amdgcn_mfma_f32_16x16x32_bf16(Bt[n][k], At[m][k], acc[ai][bj][m][n], 0, 0, 0); __builtin_amdgcn_s_setprio(0); } while (0)
#define PG8_WAIT_V(n) asm volatile("s_waitcnt vmcnt(" #n ")" ::: "memory")
#define PG8_WAIT_L(n) asm volatile("s_waitcnt lgkmcnt(" #n ")" ::: "memory")
#define PG8_BAR __builtin_amdgcn_s_barrier()
#define PG8_SCHED __builtin_amdgcn_sched_barrier(0)
    Unit cur, nxt; int ui = 0;
    if (!S.next(0, cur)) return;
    f32x4 acc[2][2][4][2];
#pragma unroll
    for (int a = 0; a < 2; ++a)
#pragma unroll
        for (int b = 0; b < 2; ++b)
#pragma unroll
            for (int m = 0; m < 4; ++m)
#pragma unroll
                for (int n = 0; n < 2; ++n) acc[a][b][m][n] = (f32x4){0.f, 0.f, 0.f, 0.f};
    bf16x8 At[4][2], B0[2][2], B1[2][2];
    const char* cA = (const char*)g.A + (size_t)cur.pm * tstep; const char* cB = (const char*)g.Bt + (size_t)cur.pn * tstep;
    S.a_ready(cur);
    if constexpr (SP2) {
        PG8_STAGE(PG8_SB(0, 0), cB, voffB); PG8_STAGE(PG8_SB(0, 1), cB + hstep, voffB); PG8_STAGE(PG8_SA(0, 0), cA, voffA); PG8_STAGE(PG8_SA(0, 1), cA + hstep, voffA);
        if (wr == 1) PG8_BAR;
        PG8_WAIT_V(2); PG8_BAR;
        PG8_STAGE(PG8_SB(1, 0), cB + kstep, voffB); PG8_STAGE(PG8_SA(1, 0), cA + kstep, voffA); PG8_STAGE(PG8_SB(1, 1), cB + hstep + kstep, voffB);
        PG8_WAIT_V(6); PG8_BAR;
    } else {
        PG8_STAGE(PG8_SB(0, 0), cB, voffB); PG8_STAGE(PG8_SA(0, 0), cA, voffA); PG8_STAGE(PG8_SB(0, 1), cB + hstep, voffB); PG8_STAGE(PG8_SA(0, 1), cA + hstep, voffA);
        if (wr == 1) PG8_BAR;
        PG8_WAIT_V(4); PG8_BAR;
        PG8_STAGE(PG8_SB(1, 0), cB + kstep, voffB); PG8_STAGE(PG8_SA(1, 0), cA + kstep, voffA); PG8_STAGE(PG8_SB(1, 1), cB + hstep + kstep, voffB);
        PG8_WAIT_V(6); PG8_BAR;
    }
    for (;;) {
        const bool has_next = S.next(ui + 1, nxt);
        const char* nA = has_next ? (const char*)g.A + (size_t)nxt.pm * tstep : cA; const char* nB = has_next ? (const char*)g.Bt + (size_t)nxt.pn * tstep : cB;
        for (int t = 0; t < nt; t += 2) {
            const bool last = (t == nt - 2);
            const char* a1 = cA + (size_t)(t + 1) * kstep;
            const char* a2 = last ? nA : cA + (size_t)(t + 2) * kstep; const char* b2 = last ? nB : cB + (size_t)(t + 2) * kstep;
            const char* a3 = a2 + kstep; const char* b3 = b2 + kstep;
            if (last && has_next) S.a_ready(nxt);
            if constexpr (SP2) {
            PG8_LDB(B0, 0, 0); PG8_LDB(B1, 0, 1); PG8_SCHED; PG8_LDA(At, 0, 0); PG8_STAGE(PG8_SA(1, 1), a1 + hstep, voffA);
            PG8_WAIT_V(8); PG8_WAIT_L(0); PG8_BAR; PG8_MMA(0, 0, At, B0); PG8_MMA(0, 1, At, B1); PG8_BAR; PG8_SCHED;
            PG8_LDA(At, 0, 1); PG8_STAGE(PG8_SB(0, 0), b2, voffB); PG8_STAGE(PG8_SB(0, 1), b2 + hstep, voffB); PG8_STAGE(PG8_SA(0, 0), a2, voffA);
            PG8_WAIT_V(8); PG8_WAIT_L(0); PG8_BAR; PG8_MMA(1, 0, At, B0); PG8_MMA(1, 1, At, B1); PG8_BAR; PG8_SCHED;
            PG8_LDB(B0, 1, 0); PG8_LDB(B1, 1, 1); PG8_SCHED; PG8_LDA(At, 1, 0); PG8_STAGE(PG8_SA(0, 1), a2 + hstep, voffA);
            PG8_WAIT_V(8); PG8_WAIT_L(0); PG8_BAR; PG8_MMA(0, 0, At, B0); PG8_MMA(0, 1, At, B1); PG8_BAR; PG8_SCHED;
            PG8_LDA(At, 1, 1); PG8_STAGE(PG8_SB(1, 0), b3, voffB); PG8_STAGE(PG8_SB(1, 1), b3 + hstep, voffB); PG8_STAGE(PG8_SA(1, 0), a3, voffA);
            PG8_WAIT_V(8); PG8_WAIT_L(0); PG8_BAR; PG8_MMA(1, 0, At, B0); PG8_MMA(1, 1, At, B1); PG8_BAR; PG8_SCHED;
            } else {
            PG8_LDB(B0, 0, 0); PG8_SCHED; PG8_LDA(At, 0, 0); PG8_STAGE(PG8_SA(1, 1), a1 + hstep, voffA);
            PG8_WAIT_L(8); PG8_BAR; PG8_WAIT_L(0); PG8_MMA(0, 0, At, B0); PG8_BAR; PG8_SCHED;
            PG8_LDB(B1, 0, 1); PG8_STAGE(PG8_SB(0, 0), b2, voffB);
            PG8_BAR; PG8_WAIT_L(0); PG8_MMA(0, 1, At, B1); PG8_BAR;
            PG8_LDA(At, 0, 1); PG8_STAGE(PG8_SA(0, 0), a2, voffA);
            PG8_BAR; PG8_WAIT_L(0); PG8_MMA(1, 0, At, B0); PG8_BAR; PG8_SCHED;
            PG8_STAGE(PG8_SB(0, 1), b2 + hstep, voffB);
            PG8_WAIT_V(6); PG8_BAR; PG8_MMA(1, 1, At, B1); PG8_BAR;
            PG8_LDB(B0, 1, 0); PG8_SCHED; PG8_LDA(At, 1, 0); PG8_STAGE(PG8_SA(0, 1), a2 + hstep, voffA);
            PG8_WAIT_L(8); PG8_BAR; PG8_WAIT_L(0); PG8_MMA(0, 0, At, B0); PG8_BAR; PG8_SCHED;
            PG8_LDB(B1, 1, 1); PG8_STAGE(PG8_SB(1, 0), b3, voffB);
            PG8_BAR; PG8_WAIT_L(0); PG8_MMA(0, 1, At, B1); PG8_BAR;
            PG8_LDA(At, 1, 1); PG8_STAGE(PG8_SA(1, 0), a3, voffA);
            PG8_BAR; PG8_WAIT_L(0); PG8_MMA(1, 0, At, B0); PG8_BAR; PG8_SCHED;
            PG8_STAGE(PG8_SB(1, 1), b3 + hstep, voffB);
            PG8_WAIT_V(6); PG8_BAR; PG8_MMA(1, 1, At, B1); PG8_BAR;
            }
        }
        if constexpr (ALIGN_EPI) { if (wr == 0) PG8_BAR; }
        if constexpr (!Epi::AFTER_DRAIN) { E(acc, cur, wr, wc, fr, fq); S.done(cur); }
        if (!has_next) break;
#pragma unroll
        for (int a = 0; a < 2; ++a)
#pragma unroll
            for (int b = 0; b < 2; ++b)
#pragma unroll
                for (int m = 0; m < 4; ++m)
#pragma unroll
                    for (int n = 0; n < 2; ++n) acc[a][b][m][n] = (f32x4){0.f, 0.f, 0.f, 0.f};
        cur = nxt; cA = nA; cB = nB; ++ui;
        if constexpr (ALIGN_EPI) { if (wr == 1) PG8_BAR; }
    }
    PG8_WAIT_V(0);
    if constexpr (!ALIGN_EPI) { if (wr == 0) PG8_BAR; }
    PG8_BAR;
    if constexpr (Epi::AFTER_DRAIN) { E.fused(acc, cur, wr, wc, fr, fq, lds, wid, lane); S.done(cur); }
#undef PG8_SA
#undef PG8_SB
#undef PG8_STAGE
#undef PG8_LDA
#undef PG8_LDB
#undef PG8_MMA
#undef PG8_WAIT_V
#undef PG8_WAIT_L
#undef PG8_BAR
#undef PG8_SCHED
}
}
using pg8::bf16x8; using pg8::f32x4; using pg8::u32x4;

constexpr size_t MiB = 1u << 20;
constexpr size_t WS_CTL = 0, CTL_ZERO_BYTES = 64 * 1024;
constexpr size_t WS_WIN = 1 * MiB;
constexpr size_t WS_WAB = 19 * MiB;
constexpr size_t WS_WO = 23 * MiB;
constexpr size_t WS_WGU = 25 * MiB;
constexpr size_t WS_WD = 36 * MiB;
constexpr size_t WS_XN = 48 * MiB;
constexpr size_t WS_MERGED = WS_XN;
constexpr size_t WS_RSTD1 = 113 * MiB;
constexpr size_t WS_BETA = 114 * MiB;
constexpr size_t WS_G = 116 * MiB;
constexpr size_t WS_RSS = 118 * MiB;
constexpr size_t WS_PARTO = 121 * MiB;
constexpr size_t WS_PARTL = 129 * MiB;
constexpr size_t WS_QKW = 129 * MiB + 512 * 1024;
constexpr size_t WS_QB = 130 * MiB;
constexpr size_t WS_KB = 195 * MiB;
constexpr size_t WS_VB = 260 * MiB;
constexpr size_t WS_TMPB = WS_KB;
constexpr size_t WS_X1B = WS_QB;
constexpr size_t WS_DQKV = 325 * MiB;
constexpr size_t WS_OAB = WS_DQKV;
constexpr size_t WS_QKVC = 520 * MiB;
constexpr size_t WS_ACT = WS_QKVC;
constexpr size_t WS_DG = 715 * MiB;
constexpr size_t WS_GA = 780 * MiB;
constexpr size_t WS_GB = 845 * MiB;
constexpr size_t WS_END = 910 * MiB;
constexpr int CW_Q2 = 64, CW_Q3 = 128;

constexpr int LDS_BYTES = 147456;
constexpr int NWAVES = 8, NTHREADS = 512;

typedef unsigned short bf16;
__device__ __forceinline__ unsigned pk2(float lo, float hi) { f32x2 v = {lo, hi}; bf16x2_t b = __builtin_convertvector(v, bf16x2_t); return __builtin_bit_cast(unsigned, b); }
__device__ __forceinline__ float bflo(unsigned w) { return __uint_as_float(w << 16); }
__device__ __forceinline__ float bfhi(unsigned w) { return __uint_as_float(w & 0xffff0000u); }
__device__ __forceinline__ float bf1(unsigned short h) { return __uint_as_float((unsigned)h << 16); }
__device__ __forceinline__ float wave_sum(float v) {
#pragma unroll
    for (int o = 1; o < 64; o <<= 1) v += __shfl_xor(v, o);
    return v;
}
__device__ __forceinline__ float sigmoidf_(float x) { return 1.f / (1.f + __expf(-x)); }
#define LDS_WAIT() asm volatile("s_waitcnt lgkmcnt(0)" ::: "memory")

struct Args {
    const float* in[25]; float* out; unsigned char* ws; int ph_lo, ph_hi;
};

struct Frame {
    LAS unsigned char* lds;
    unsigned char* ws; float* out;
    const float* const* in;
    int tid, lane, wave, G, bid;
};

__device__ __forceinline__ void tr_item(const float* W, int Nsrc, int scol0, int k0, bf16* WT, int K, int drow0, const float* ksc, LAS float* scr, int lane) {
#pragma unroll 8
    for (int i = 0; i < 32; ++i) { const int kk = 2 * i + (lane >> 5); float v = W[(size_t)(k0 + kk) * Nsrc + scol0 + (lane & 31)]; if (ksc) v *= ksc[k0 + kk]; scr[kk * 33 + (lane & 31)] = v; }
    LDS_WAIT(); asm volatile("" ::: "memory");
    const int c = lane & 7;
#pragma unroll
    for (int j = 0; j < 4; ++j) { const int n = (lane >> 3) + 8 * j; const LAS float* s = scr + (8 * c) * 33 + n;
        u32x4 o; o.x = pk2(s[0 * 33], s[1 * 33]); o.y = pk2(s[2 * 33], s[3 * 33]); o.z = pk2(s[4 * 33], s[5 * 33]); o.w = pk2(s[6 * 33], s[7 * 33]);
        *(u32x4*)(WT + (size_t)(drow0 + n) * K + k0 + 8 * c) = o; }
    LDS_WAIT(); asm volatile("" ::: "memory");
}

__device__ __forceinline__ void p0_prologue(const Frame& F) {
    const float* xp = F.in[0]; const float* xs = F.in[1]; const float* ln1 = F.in[6]; const float* w_in = F.in[7];
    const float* w_a = F.in[15]; const float* w_b = F.in[20]; const float* w_o = F.in[21]; const float* ln2 = F.in[22]; const float* w_gu = F.in[23]; const float* w_d = F.in[24];
    const float* a_log = F.in[17]; const float* dt_bias = F.in[18];
    bf16* WinT = (bf16*)(F.ws + WS_WIN); bf16* WabT = (bf16*)(F.ws + WS_WAB); bf16* WoT = (bf16*)(F.ws + WS_WO); bf16* WguT = (bf16*)(F.ws + WS_WGU); bf16* WdT = (bf16*)(F.ws + WS_WD);
    bf16* XN = (bf16*)(F.ws + WS_XN); float* RSTD1 = (float*)(F.ws + WS_RSTD1); float* BETA = (float*)(F.ws + WS_BETA); float* GARR = (float*)(F.ws + WS_G);
    LAS bf16* W16h = (LAS bf16*)(F.lds); LAS bf16* W16l = (LAS bf16*)(F.lds + 32768);
    LAS float* scr = (LAS float*)(F.lds + 65536 + F.wave * 8448);
    for (int idx = F.tid; idx < 16384; idx += NTHREADS) { const int k = idx >> 4, c = idx & 15; const float v = w_in[(size_t)k * DIN + 7168 + c] * ln1[k];
        const unsigned hi = pk2(v, 0.f) & 0xffffu; const float r = v - bf1((unsigned short)hi); const unsigned lo = pk2(r, 0.f) & 0xffffu;
        const int off = ((((k >> 5) * 4 + ((k >> 3) & 3)) * 16 + c) << 3) + (k & 7); W16h[off] = (bf16)hi; W16l[off] = (bf16)lo; }
    if (F.bid == 0 && F.tid < 128) ((float*)(F.ws + WS_QKW))[F.tid] = F.tid < 64 ? F.in[8][F.tid] : F.in[9][F.tid - 64];
    const int gw = F.bid * NWAVES + F.wave, NGW = F.G * NWAVES;
    constexpr int I_IN = 16 * (NZ / 32), I_AB = 16 * 64, I_O = 16 * 32, I_GU = 16 * (2 * DFF / 32), I_D = (DFF / 64) * 32;
    constexpr int NITEMS = I_IN + I_AB + I_O + I_GU + I_D;
    for (int it = gw; it < NITEMS; it += NGW) {
        int r = it;
        if (r < I_IN) { const int kb = r / (NZ / 32), nb = r % (NZ / 32); const int n = nb * 32, pn = n >> 8, T = n & 255, bj = T >> 7, g = (T & 127) >> 5; const int zc = 256 * pn + 64 * g + 32 * bj;
            tr_item(w_in, DIN, zc < 7168 ? zc : zc + 16, kb * 64, WinT, DM, n, ln1, scr, F.lane); continue; } r -= I_IN;
        if (r < I_AB) { const int kb = r / 64, nb = r % 64; const int n = nb * 32; tr_item(n < 1024 ? w_a : w_b, DM, n & 1023, kb * 64, WabT, DM, n, nullptr, scr, F.lane); continue; } r -= I_AB;
        if (r < I_O) { const int kb = r / 32, nb = r % 32; tr_item(w_o, DM, nb * 32, kb * 64, WoT, DM, nb * 32, nullptr, scr, F.lane); continue; } r -= I_O;
        if (r < I_GU) { const int kb = r / (2 * DFF / 32), nb = r % (2 * DFF / 32); const int n = nb * 32, pn = n >> 8, T = n & 255, bj = T >> 7, cc = T & 127;
            tr_item(w_gu, 2 * DFF, bj * DFF + 128 * pn + cc, kb * 64, WguT, DM, n, ln2, scr, F.lane); continue; } r -= I_GU;
        { const int kb = r / 32, nb = r % 32; tr_item(w_d, DM, nb * 32, kb * 64, WdT, DFF, nb * 32, nullptr, scr, F.lane); }
    }
    __syncthreads();
    const int fr = F.lane & 15, fq = F.lane >> 4;
    for (int grp = gw; grp < MT / 16; grp += NGW) {
        const int row = grp * 16 + fr;
        const float* xr = (row < MP ? xp + (size_t)row * DM : xs + (size_t)(row - MP) * DM) + 8 * fq;
        bf16* xo = XN + (size_t)row * DM + 8 * fq;
        f32x4 acc = {0.f, 0.f, 0.f, 0.f}; float ss = 0.f;
#pragma unroll 1
        for (int s8 = 0; s8 < 32; s8 += 8) {
            f32x4 av[8], bv[8];
#pragma unroll
            for (int u = 0; u < 8; ++u) { av[u] = *(const f32x4*)(xr + 32 * (s8 + u)); bv[u] = *(const f32x4*)(xr + 32 * (s8 + u) + 4); }
#pragma unroll
            for (int u = 0; u < 8; ++u) { const int s = s8 + u; const f32x4 a = av[u], b = bv[u];
                ss += (a.x * a.x + a.y * a.y) + (a.z * a.z + a.w * a.w) + (b.x * b.x + b.y * b.y) + (b.z * b.z + b.w * b.w);
                u32x4 hw; hw.x = pk2(a.x, a.y); hw.y = pk2(a.z, a.w); hw.z = pk2(b.x, b.y); hw.w = pk2(b.z, b.w);
                *(u32x4*)(xo + 32 * s) = hw;
                u32x4 lw; lw.x = pk2(a.x - bflo(hw.x), a.y - bfhi(hw.x)); lw.y = pk2(a.z - bflo(hw.y), a.w - bfhi(hw.y)); lw.z = pk2(b.x - bflo(hw.z), b.y - bfhi(hw.z)); lw.w = pk2(b.z - bflo(hw.w), b.w - bfhi(hw.w));
                const bf16x8 wh = *(const LAS bf16x8*)(W16h + (((s * 4 + fq) * 16 + fr) << 3)), wl = *(const LAS bf16x8*)(W16l + (((s * 4 + fq) * 16 + fr) << 3));
                const bf16x8 xh = __builtin_bit_cast(bf16x8, hw), xl = __builtin_bit_cast(bf16x8, lw);
                acc = __builtin_amdgcn_mfma_f32_16x16x32_bf16(wh, xh, acc, 0, 0, 0);
                acc = __builtin_amdgcn_mfma_f32_16x16x32_bf16(wh, xl, acc, 0, 0, 0);
                acc = __builtin_amdgcn_mfma_f32_16x16x32_bf16(wl, xh, acc, 0, 0, 0); }
        }
        ss += __shfl_xor(ss, 16); ss += __shfl_xor(ss, 32);
        const float rstd = rsqrtf(ss * (1.f / DM) + EPS);
        if (fq == 0) RSTD1[row] = rstd;
        if (fq < 2) { f32x4 o; o.x = sigmoidf_(acc.x * rstd); o.y = sigmoidf_(acc.y * rstd); o.z = sigmoidf_(acc.z * rstd); o.w = sigmoidf_(acc.w * rstd); *(f32x4*)(BETA + (size_t)row * 8 + 4 * fq) = o; }
        else { const int h0 = 4 * (fq - 2); f32x4 o;
#pragma unroll
            for (int i = 0; i < 4; ++i) { const float z = acc[i] * rstd + dt_bias[h0 + i]; const float sp = z > 20.f ? z : log1pf(__expf(z)); o[i] = -__expf(a_log[h0 + i]) * sp; }
            *(f32x4*)(GARR + (size_t)row * 8 + h0) = o; }
    }
}

namespace pg8 {
struct PairOrder {
    int G, c;
    __device__ bool next(int i, Unit& u) const { const int P = (i >> 1) * G + c; if (P >= 130 * 4) return false; const int s = i & 1; u.pm = (P >> 2) + 130 * s; u.pn = (P & 3) + 4 * s; return true; }
    __device__ __forceinline__ void a_ready(const Unit&) const {}
    __device__ __forceinline__ void done(const Unit&) const {}
};

struct EpiZ {
    static constexpr bool PERM = true, AFTER_DRAIN = false;
    unsigned char* ws; float* out;
    __device__ __forceinline__ void operator()(const f32x4 (&acc)[2][2][4][2], const Unit& u, int wr, int wc, int fr, int fq) const {
        const int pn = u.pn, row0 = u.pm * BM + wr * 64 + fr;
        const float* rstd = (const float*)(ws + WS_RSTD1);
        f32x4 wv[2][2];
        if (pn < 8) { const float* w = (const float*)(ws + WS_QKW) + (pn < 4 ? 0 : 64); const float sc = pn < 4 ? QSCALE : 1.f;
#pragma unroll
            for (int bj = 0; bj < 2; ++bj)
#pragma unroll
                for (int n = 0; n < 2; ++n) wv[bj][n] = *(const f32x4*)(w + 32 * bj + 8 * fq + 4 * n) * sc; }
        float rsv[2][4];
#pragma unroll
        for (int ai = 0; ai < 2; ++ai)
#pragma unroll
            for (int m = 0; m < 4; ++m) rsv[ai][m] = rstd[row0 + ai * HALF + m * 16];
#pragma unroll
        for (int ai = 0; ai < 2; ++ai)
#pragma unroll
            for (int m = 0; m < 4; ++m) {
                const int row = row0 + ai * HALF + m * 16; const float rs = rsv[ai][m];
                f32x4 v[2][2];
#pragma unroll
                for (int bj = 0; bj < 2; ++bj)
#pragma unroll
                    for (int n = 0; n < 2; ++n) v[bj][n] = acc[ai][bj][m][n] * rs;
                const int lc = 64 * wc + 8 * fq;
                if (pn < 8) {
                    float ss = 0.f;
#pragma unroll
                    for (int bj = 0; bj < 2; ++bj)
#pragma unroll
                        for (int n = 0; n < 2; ++n) ss += (v[bj][n].x * v[bj][n].x + v[bj][n].y * v[bj][n].y) + (v[bj][n].z * v[bj][n].z + v[bj][n].w * v[bj][n].w);
                    ss += __shfl_xor(ss, 16); ss += __shfl_xor(ss, 32);
                    const float r = rsqrtf(ss * (1.f / 64.f) + EPS);
                    bf16_t* dst = (bf16_t*)(ws + (pn < 4 ? WS_QB : WS_KB)) + (size_t)row * DM + (pn & 3) * 256 + lc;
                    float* ko = out + (row < MP ? OFF_KP + (size_t)row * DM : OFF_KS + (size_t)(row - MP) * DM) + (pn & 3) * 256 + lc;
#pragma unroll
                    for (int bj = 0; bj < 2; ++bj) { const f32x4 o0 = v[bj][0] * r * wv[bj][0], o1 = v[bj][1] * r * wv[bj][1];
                        u32x4 w; w.x = pk2(o0.x, o0.y); w.y = pk2(o0.z, o0.w); w.z = pk2(o1.x, o1.y); w.w = pk2(o1.z, o1.w);
                        *(u32x4*)(dst + 32 * bj) = w;
                        if (pn >= 4) { *(f32x4*)(ko + 32 * bj) = o0; *(f32x4*)(ko + 32 * bj + 4) = o1; } }
                } else if (pn < 12) {
                    bf16_t* dst = (bf16_t*)(ws + WS_VB) + (size_t)row * DM + (pn - 8) * 256 + lc;
                    float* vo = out + (row < MP ? OFF_VP + (size_t)row * DM : OFF_VS + (size_t)(row - MP) * DM) + (pn - 8) * 256 + lc;
#pragma unroll
                    for (int bj = 0; bj < 2; ++bj) { u32x4 w; w.x = pk2(v[bj][0].x, v[bj][0].y); w.y = pk2(v[bj][0].z, v[bj][0].w); w.z = pk2(v[bj][1].x, v[bj][1].y); w.w = pk2(v[bj][1].z, v[bj][1].w);
                        *(u32x4*)(dst + 32 * bj) = w; *(f32x4*)(vo + 32 * bj) = v[bj][0]; *(f32x4*)(vo + 32 * bj + 4) = v[bj][1]; }
                } else if (pn < 24) {
                    const int col = (pn - 12) * 256 + lc; bf16_t* dst = (bf16_t*)(ws + WS_DQKV) + (size_t)row * CONVCH + col;
                    int cr = -1; float* co = nullptr;
                    if (row < MP) { const int t = row & (SEQ - 1); if (t >= SEQ - 3) { cr = t - (SEQ - 3); co = out + OFF_CP + ((size_t)(row >> 11) * 3 + cr) * CONVCH + col; } }
                    else { const int t = (row - MP) & (DSEQ - 1); if (t >= DSEQ - 3) { cr = t - (DSEQ - 3); co = out + OFF_CS + ((size_t)((row - MP) >> 5) * 3 + cr) * CONVCH + col; } }
#pragma unroll
                    for (int bj = 0; bj < 2; ++bj) { u32x4 w; w.x = pk2(v[bj][0].x, v[bj][0].y); w.y = pk2(v[bj][0].z, v[bj][0].w); w.z = pk2(v[bj][1].x, v[bj][1].y); w.w = pk2(v[bj][1].z, v[bj][1].w);
                        *(u32x4*)(dst + 32 * bj) = w; if (cr >= 0) { *(f32x4*)(co + 32 * bj) = v[bj][0]; *(f32x4*)(co + 32 * bj + 4) = v[bj][1]; } }
                } else {
                    bf16_t* dst = (bf16_t*)(ws + (pn < 28 ? WS_DG : (pn < 32 ? WS_GA : WS_GB))) + (size_t)row * DM + (pn & 3) * 256 + lc;
                    const bool sg = pn >= 28;
#pragma unroll
                    for (int bj = 0; bj < 2; ++bj) { f32x4 a = v[bj][0], b = v[bj][1];
                        if (sg) { a.x = sigmoidf_(a.x); a.y = sigmoidf_(a.y); a.z = sigmoidf_(a.z); a.w = sigmoidf_(a.w); b.x = sigmoidf_(b.x); b.y = sigmoidf_(b.y); b.z = sigmoidf_(b.z); b.w = sigmoidf_(b.w); }
                        u32x4 w; w.x = pk2(a.x, a.y); w.y = pk2(a.z, a.w); w.z = pk2(b.x, b.y); w.w = pk2(b.z, b.w); *(u32x4*)(dst + 32 * bj) = w; }
                }
                asm volatile("" ::: "memory");
            }
    }
};

struct EpiAB {
    static constexpr bool PERM = true, AFTER_DRAIN = false;
    unsigned char* ws; float* unused_;
    __device__ __forceinline__ void operator()(const f32x4 (&acc)[2][2][4][2], const Unit& u, int wr, int wc, int fr, int fq) const {
        const int s = u.pm >= 130 ? 1 : 0; const int pm = u.pm - 130 * s, pn = u.pn - 4 * s;
        const int row0 = pm * BM + wr * 64 + fr, col0 = pn * BM + wc * 32 + 8 * fq;
        const bf16_t* G = (const bf16_t*)(ws + (s ? WS_GB : WS_GA)); bf16_t* TMPB = (bf16_t*)(ws + WS_TMPB); bf16_t* dstb = (bf16_t*)(ws + (s ? WS_MERGED : WS_TMPB));
#pragma unroll
        for (int ai = 0; ai < 2; ++ai) {
            u32x4 g[4][2], t[4][2];
#pragma unroll
            for (int m = 0; m < 4; ++m)
#pragma unroll
                for (int bj = 0; bj < 2; ++bj) { const size_t off = (size_t)(row0 + ai * HALF + m * 16) * DM + col0 + bj * HALF; g[m][bj] = *(const u32x4*)(G + off);
                    t[m][bj] = s ? *(const u32x4*)(TMPB + off) : (u32x4){0u, 0u, 0u, 0u}; }
#pragma unroll
            for (int m = 0; m < 4; ++m)
#pragma unroll
                for (int bj = 0; bj < 2; ++bj) { const size_t off = (size_t)(row0 + ai * HALF + m * 16) * DM + col0 + bj * HALF; const u32x4 gg = g[m][bj], tt = t[m][bj];
                    f32x4 a = acc[ai][bj][m][0], b = acc[ai][bj][m][1];
                    a.x = a.x * bflo(gg.x) + bflo(tt.x); a.y = a.y * bfhi(gg.x) + bfhi(tt.x); a.z = a.z * bflo(gg.y) + bflo(tt.y); a.w = a.w * bfhi(gg.y) + bfhi(tt.y);
                    b.x = b.x * bflo(gg.z) + bflo(tt.z); b.y = b.y * bfhi(gg.z) + bfhi(tt.z); b.z = b.z * bflo(gg.w) + bflo(tt.w); b.w = b.w * bfhi(gg.w) + bfhi(tt.w);
                    u32x4 w; w.x = pk2(a.x, a.y); w.y = pk2(a.z, a.w); w.z = pk2(b.x, b.y); w.w = pk2(b.z, b.w); *(u32x4*)(dstb + off) = w; }
            asm volatile("" ::: "memory");
        }
    }
};

struct EpiOut {
    static constexpr bool PERM = true, AFTER_DRAIN = false;
    const float* xp; const float* xs; float* out; bf16_t* X1B; float* RSS;
    __device__ __forceinline__ void operator()(const f32x4 (&acc)[2][2][4][2], const Unit& u, int wr, int wc, int fr, int fq) const {
        const int row0 = u.pm * BM + wr * 64 + fr, col0 = u.pn * BM + wc * 32 + 8 * fq;
#pragma unroll
        for (int ai = 0; ai < 2; ++ai) {
            f32x4 xr_[4][2][2];
#pragma unroll
            for (int m = 0; m < 4; ++m) { const int row = row0 + ai * HALF + m * 16; const float* xr = (row < MP ? xp + (size_t)row * DM : xs + (size_t)(row - MP) * DM) + col0;
#pragma unroll
                for (int bj = 0; bj < 2; ++bj) { xr_[m][bj][0] = *(const f32x4*)(xr + bj * HALF); xr_[m][bj][1] = *(const f32x4*)(xr + bj * HALF + 4); } }
#pragma unroll
            for (int m = 0; m < 4; ++m) { const int row = row0 + ai * HALF + m * 16; const size_t off = (size_t)row * DM + col0; float ss = 0.f;
#pragma unroll
                for (int bj = 0; bj < 2; ++bj) { const f32x4 a = acc[ai][bj][m][0] + xr_[m][bj][0], b = acc[ai][bj][m][1] + xr_[m][bj][1];
                    ss += (a.x * a.x + a.y * a.y) + (a.z * a.z + a.w * a.w) + (b.x * b.x + b.y * b.y) + (b.z * b.z + b.w * b.w);
                    *(f32x4*)(out + off + bj * HALF) = a; *(f32x4*)(out + off + bj * HALF + 4) = b;
                    u32x4 w; w.x = pk2(a.x, a.y); w.y = pk2(a.z, a.w); w.z = pk2(b.x, b.y); w.w = pk2(b.z, b.w); *(u32x4*)(X1B + off + bj * HALF) = w; }
                ss += __shfl_xor(ss, 16); ss += __shfl_xor(ss, 32);
                if (fq == 0) RSS[(size_t)row * 16 + u.pn * 4 + wc] = ss; }
            asm volatile("" ::: "memory");
        }
    }
};

struct EpiGU {
    static constexpr bool PERM = true, AFTER_DRAIN = false;
    const float* RSS; bf16_t* ACT;
    __device__ __forceinline__ void operator()(const f32x4 (&acc)[2][2][4][2], const Unit& u, int wr, int wc, int fr, int fq) const {
        const int row0 = u.pm * BM + wr * 64 + fr, col0 = u.pn * 128 + wc * 32 + 8 * fq;
        float rsv[2][4];
#pragma unroll
        for (int ai = 0; ai < 2; ++ai) { f32x4 rr[4][4];
#pragma unroll
            for (int m = 0; m < 4; ++m) { const f32x4* rp = (const f32x4*)(RSS + (size_t)(row0 + ai * HALF + m * 16) * 16); rr[m][0] = rp[0]; rr[m][1] = rp[1]; rr[m][2] = rp[2]; rr[m][3] = rp[3]; }
#pragma unroll
            for (int m = 0; m < 4; ++m) { const f32x4 r0 = rr[m][0], r1 = rr[m][1], r2 = rr[m][2], r3 = rr[m][3];
                const float ss = ((r0.x + r0.y) + (r0.z + r0.w)) + ((r1.x + r1.y) + (r1.z + r1.w)) + ((r2.x + r2.y) + (r2.z + r2.w)) + ((r3.x + r3.y) + (r3.z + r3.w));
                rsv[ai][m] = rsqrtf(ss * (1.f / DM) + EPS); } }
#pragma unroll
        for (int ai = 0; ai < 2; ++ai)
#pragma unroll
            for (int m = 0; m < 4; ++m) { const int row = row0 + ai * HALF + m * 16; const float rs = rsv[ai][m];
                f32x4 o[2];
#pragma unroll
                for (int n = 0; n < 2; ++n) { const f32x4 g = acc[ai][0][m][n] * rs, uu = acc[ai][1][m][n] * rs;
                    o[n].x = g.x * sigmoidf_(g.x) * uu.x; o[n].y = g.y * sigmoidf_(g.y) * uu.y; o[n].z = g.z * sigmoidf_(g.z) * uu.z; o[n].w = g.w * sigmoidf_(g.w) * uu.w; }
                u32x4 w; w.x = pk2(o[0].x, o[0].y); w.y = pk2(o[0].z, o[0].w); w.z = pk2(o[1].x, o[1].y); w.w = pk2(o[1].z, o[1].w);
                *(u32x4*)(ACT + (size_t)row * DFF + col0) = w; }
    }
};

struct EpiDown {
    static constexpr bool PERM = true, AFTER_DRAIN = false;
    float* out;
    __device__ __forceinline__ void operator()(const f32x4 (&acc)[2][2][4][2], const Unit& u, int wr, int wc, int fr, int fq) const {
        const int row0 = u.pm * BM + wr * 64 + fr, col0 = u.pn * BM + wc * 32 + 8 * fq;
#pragma unroll
        for (int ai = 0; ai < 2; ++ai) {
            f32x4 x1[4][2][2];
#pragma unroll
            for (int m = 0; m < 4; ++m) { const float* o = out + (size_t)(row0 + ai * HALF + m * 16) * DM + col0;
#pragma unroll
                for (int bj = 0; bj < 2; ++bj) { x1[m][bj][0] = *(const f32x4*)(o + bj * HALF); x1[m][bj][1] = *(const f32x4*)(o + bj * HALF + 4); } }
#pragma unroll
            for (int m = 0; m < 4; ++m) { float* o = out + (size_t)(row0 + ai * HALF + m * 16) * DM + col0;
#pragma unroll
                for (int bj = 0; bj < 2; ++bj) { *(f32x4*)(o + bj * HALF) = x1[m][bj][0] + acc[ai][bj][m][0]; *(f32x4*)(o + bj * HALF + 4) = x1[m][bj][1] + acc[ai][bj][m][1]; } }
            asm volatile("" ::: "memory");
        }
    }
};
}

__device__ __forceinline__ float lambda_of(const Frame& F) {
    const float* q1 = F.in[10]; const float* k1 = F.in[11]; const float* q2 = F.in[12]; const float* k2 = F.in[13];
    float a = 0.f, b = 0.f;
    for (int i = 0; i < 64; ++i) { a += q1[i] * k1[i]; b += q2[i] * k2[i]; }
    return __expf(a) - __expf(b) + LAM_INIT;
}

__device__ __forceinline__ void conv_task(const Frame& F, int task) {
    const bf16* DQKV = (const bf16*)(F.ws + WS_DQKV); bf16* QKVC = (bf16*)(F.ws + WS_QKVC);
    const float* conv_w = F.in[16]; const float* sconv = F.in[5];
    int lane_ = F.lane; asm volatile("" : "+v"(lane_)); const int run = task / 6, cgp = task % 6; const int c0 = cgp * 512 + lane_ * 8; const int r0 = run * 32;
    const bool sample = r0 >= MP; const int t0 = sample ? 0 : (r0 & (SEQ - 1));
    float w[4][8];
#pragma unroll
    for (int j = 0; j < 4; ++j) { const f32x4 a = *(const f32x4*)(conv_w + j * CONVCH + c0), b = *(const f32x4*)(conv_w + j * CONVCH + c0 + 4); w[j][0] = a.x; w[j][1] = a.y; w[j][2] = a.z; w[j][3] = a.w; w[j][4] = b.x; w[j][5] = b.y; w[j][6] = b.z; w[j][7] = b.w; }
    float h[3][8];
#pragma unroll
    for (int j = 0; j < 3; ++j) {
        if (t0 > 0) { const u32x4 v = *(const u32x4*)(DQKV + (size_t)(r0 - 3 + j) * CONVCH + c0); h[j][0] = bflo(v.x); h[j][1] = bfhi(v.x); h[j][2] = bflo(v.y); h[j][3] = bfhi(v.y); h[j][4] = bflo(v.z); h[j][5] = bfhi(v.z); h[j][6] = bflo(v.w); h[j][7] = bfhi(v.w); }
        else if (sample) { const float* s = sconv + ((size_t)((r0 - MP) >> 5) * 3 + j) * CONVCH + c0; const f32x4 a = *(const f32x4*)s, b = *(const f32x4*)(s + 4); h[j][0] = a.x; h[j][1] = a.y; h[j][2] = a.z; h[j][3] = a.w; h[j][4] = b.x; h[j][5] = b.y; h[j][6] = b.z; h[j][7] = b.w; }
        else {
#pragma unroll
            for (int e = 0; e < 8; ++e) h[j][e] = 0.f; }
    }
    const float qs = cgp < 2 ? 0.08838834764831845f : 1.f; const bool nrm = cgp < 4;
    for (int t8 = 0; t8 < 32; t8 += 8) {
        u32x4 vv[8];
#pragma unroll
        for (int u = 0; u < 8; ++u) vv[u] = *(const u32x4*)(DQKV + (size_t)(r0 + t8 + u) * CONVCH + c0);
#pragma unroll
        for (int u = 0; u < 8; ++u) { const u32x4 v = vv[u];
            float x[8]; x[0] = bflo(v.x); x[1] = bfhi(v.x); x[2] = bflo(v.y); x[3] = bfhi(v.y); x[4] = bflo(v.z); x[5] = bfhi(v.z); x[6] = bflo(v.w); x[7] = bfhi(v.w);
            float y[8]; float ss = 0.f;
#pragma unroll
            for (int e = 0; e < 8; ++e) { float a = w[0][e] * h[0][e] + w[1][e] * h[1][e] + w[2][e] * h[2][e] + w[3][e] * x[e]; a = a * sigmoidf_(a); y[e] = a; ss += a * a; h[0][e] = h[1][e]; h[1][e] = h[2][e]; h[2][e] = x[e]; }
            if (nrm) { ss += __shfl_xor(ss, 1); ss += __shfl_xor(ss, 2); ss += __shfl_xor(ss, 4); ss += __shfl_xor(ss, 8); const float r = rsqrtf(ss + EPS) * qs;
#pragma unroll
                for (int e = 0; e < 8; ++e) y[e] *= r; }
            u32x4 o; o.x = pk2(y[0], y[1]); o.y = pk2(y[2], y[3]); o.z = pk2(y[4], y[5]); o.w = pk2(y[6], y[7]);
            *(u32x4*)(QKVC + (size_t)(r0 + t8 + u) * CONVCH + c0) = o; }
    }
}

__device__ __forceinline__ int swz_f(int r) { return ((r & 3) << 2) | ((r >> 2) & 3); }
__device__ __forceinline__ int tile_off(int r, int ch) { return 256 * r + 16 * (ch ^ swz_f(r)); }
__device__ __forceinline__ s16x4 vtr(const LAS unsigned char* p) { typedef short v4i16_t __attribute__((ext_vector_type(4))); return __builtin_bit_cast(s16x4, __builtin_amdgcn_ds_read_tr16_b64_v4i16((LAS v4i16_t*)p)); }
__device__ __forceinline__ float exp2_(float x) { return __builtin_amdgcn_exp2f(x); }

__device__ __forceinline__ f32x16 qk_block(const LAS unsigned char* KT, int kb, int m, const bf16x8 (&qf)[4], int r, int hh) {
    f32x16 s = {0.f, 0.f, 0.f, 0.f, 0.f, 0.f, 0.f, 0.f, 0.f, 0.f, 0.f, 0.f, 0.f, 0.f, 0.f, 0.f};
    const int key = 32 * kb + r; const int fz = swz_f(key);
#pragma unroll
    for (int d0 = 0; d0 < 4; ++d0) { const bf16x8 kf = *(const LAS bf16x8*)(KT + 256 * key + 16 * ((8 * m + 2 * d0 + hh) ^ fz)); s = __builtin_amdgcn_mfma_f32_32x32x16_bf16(kf, qf[d0], s, 0, 0, 0); }
    return s;
}
__device__ __forceinline__ float exp_block(f32x16& s) { float a = 0.f;
#pragma unroll
    for (int i = 0; i < 16; ++i) { s[i] = exp2_(s[i]); a += s[i]; }
    return a; }
__device__ __forceinline__ bf16x8 pfrag(const f32x16& p, int s) { u32x4 w; w.x = pk2(p[8 * s + 0], p[8 * s + 1]); w.y = pk2(p[8 * s + 2], p[8 * s + 3]); w.z = pk2(p[8 * s + 4], p[8 * s + 5]); w.w = pk2(p[8 * s + 6], p[8 * s + 7]); return __builtin_bit_cast(bf16x8, w); }
__device__ __forceinline__ bf16x8 vfrag(const LAS unsigned char* VT, int eb, int kb, int s, int lane) {
    const int hh = lane >> 5, gsel = (lane >> 4) & 1, q = (lane >> 2) & 3, p = lane & 3;
    const int row = 32 * kb + 16 * s + 4 * hh + q; const int ch = 4 * eb + 2 * gsel + (p >> 1);
    const s16x4 lo = vtr(VT + 256 * row + 16 * (ch ^ swz_f(row)) + 8 * (p & 1));
    const s16x4 hi = vtr(VT + 256 * (row + 8) + 16 * (ch ^ swz_f(row + 8)) + 8 * (p & 1));
    return (bf16x8){lo[0], lo[1], lo[2], lo[3], hi[0], hi[1], hi[2], hi[3]};
}


__device__ __forceinline__ void glds16(const void* gsrc, unsigned lds_dst) { unsigned keep;
    asm volatile("s_mov_b32 %0, m0\n\ts_mov_b32 m0, %2\n\ts_nop 0\n\tglobal_load_lds_dwordx4 %1, off\n\ts_mov_b32 m0, %0" : "=&s"(keep) : "v"(gsrc), "s"(lds_dst) : "memory"); }
template <int BUF> __device__ __forceinline__ void attn_tile(const LAS unsigned char* L, f32x16 (&O)[4], float& l, const bf16x8 (&qf)[4], int krow, int fzm, const int (&vb)[4][2]) {
    const LAS unsigned char* KT = L + BUF * 32768; const LAS unsigned char* VT = KT + 16384;
#define VLD_(dst, eb) do { _Pragma("unroll") for (int kb_ = 0; kb_ < 2; ++kb_) _Pragma("unroll") for (int s_ = 0; s_ < 2; ++s_) { \
        const s16x4 lo_ = vtr(VT + vb[eb][0] + 8192 * kb_ + 4096 * s_), hi_ = vtr(VT + vb[eb][1] + 8192 * kb_ + 4096 * s_); \
        dst[kb_ * 2 + s_] = (bf16x8){lo_[0], lo_[1], lo_[2], lo_[3], hi_[0], hi_[1], hi_[2], hi_[3]}; } } while (0)
#define PV_(src, eb) do { _Pragma("unroll") for (int ks_ = 0; ks_ < 4; ++ks_) O[eb] = __builtin_amdgcn_mfma_f32_32x32x16_bf16(src[ks_], p[ks_], O[eb], 0, 0, 0); } while (0)
    bf16x8 kf[2][4];
#pragma unroll
    for (int kb = 0; kb < 2; ++kb)
#pragma unroll
        for (int d0 = 0; d0 < 4; ++d0) kf[kb][d0] = *(const LAS bf16x8*)(KT + krow + 8192 * kb + 16 * ((2 * d0) ^ fzm));
    __builtin_amdgcn_sched_barrier(0);
    f32x16 s0, s1;
#pragma unroll
    for (int i = 0; i < 16; ++i) { s0[i] = 0.f; s1[i] = 0.f; }
    bf16x8 va[4], vc[4];
    VLD_(va, 0);
#pragma unroll
    for (int d0 = 0; d0 < 4; ++d0) { s0 = __builtin_amdgcn_mfma_f32_32x32x16_bf16(kf[0][d0], qf[d0], s0, 0, 0, 0); s1 = __builtin_amdgcn_mfma_f32_32x32x16_bf16(kf[1][d0], qf[d0], s1, 0, 0, 0); }
    __builtin_amdgcn_sched_barrier(0);
    VLD_(vc, 1);
    l += exp_block(s0) + exp_block(s1);
    bf16x8 p[4]; p[0] = pfrag(s0, 0); p[1] = pfrag(s0, 1); p[2] = pfrag(s1, 0); p[3] = pfrag(s1, 1);
    __builtin_amdgcn_sched_barrier(0);
    PV_(va, 0); VLD_(va, 2);
    __builtin_amdgcn_sched_barrier(0);
    PV_(vc, 1); VLD_(vc, 3);
    __builtin_amdgcn_sched_barrier(0);
    PV_(va, 2); PV_(vc, 3);
#undef VLD_
#undef PV_
}
__device__ __forceinline__ void attn_prompt_unit(const Frame& F, int b, int h, int qb, float lam) {
    const bf16* Qb = (const bf16*)(F.ws + WS_QB); const bf16* Kb = (const bf16*)(F.ws + WS_KB); const bf16* Vb = (const bf16*)(F.ws + WS_VB); bf16* OA = (bf16*)(F.ws + WS_OAB);
    const float* subw = F.in[14];
    int lane = F.lane; asm volatile("" : "+v"(lane)); const int w = F.wave, r = lane & 31, hh = lane >> 5, g = w & 3, m = w >> 2;
    const size_t rowbase = (size_t)b * SEQ; const int q0 = 128 * qb + 32 * g;
    const int NT = 2 * qb + 2, tmax = 2 * qb + (g >> 1);
    const LAS unsigned char* L = F.lds;
    bf16x8 qf[4];
#pragma unroll
    for (int d0 = 0; d0 < 4; ++d0) qf[d0] = *(const bf16x8*)(Qb + (rowbase + q0 + r) * DM + h * 128 + m * 64 + 16 * d0 + 8 * hh);
    asm volatile("s_waitcnt vmcnt(0)" ::: "memory");
#pragma unroll
    for (int d0 = 0; d0 < 4; ++d0) asm volatile("" : "+v"(qf[d0]));
    const int fzm = swz_f(r) ^ hh ^ (8 * m); const int krow = 256 * r;
    int vb[4][2];
    { const int gsel = (lane >> 4) & 1, q = (lane >> 2) & 3, p = lane & 3;
#pragma unroll
      for (int eb = 0; eb < 4; ++eb)
#pragma unroll
          for (int hl = 0; hl < 2; ++hl) { const int row = 4 * hh + q + 8 * hl; vb[eb][hl] = 256 * row + 16 * ((4 * eb + 2 * gsel + (p >> 1)) ^ swz_f(row)) + 8 * (p & 1); } }
    f32x16 O[4];
#pragma unroll
    for (int eb = 0; eb < 4; ++eb)
#pragma unroll
        for (int i = 0; i < 16; ++i) O[eb][i] = 0.f;
    float l = 0.f;
    const bf16* kg[2]; const bf16* vg[2];
#pragma unroll
    for (int i = 0; i < 2; ++i) { const int row = 4 * (2 * w + i) + (lane >> 4), ch = (lane & 15) ^ swz_f(row); kg[i] = Kb + (rowbase + row) * DM + h * 128 + ch * 8; vg[i] = Vb + (rowbase + row) * DM + h * 128 + ch * 8; }
    const unsigned lds0 = (unsigned)(uintptr_t)F.lds;
#define STAGE_T(t, BUF) do { const size_t o_ = (size_t)(t) * 64 * DM; _Pragma("unroll") for (int i_ = 0; i_ < 2; ++i_) { \
        glds16(kg[i_] + o_, (unsigned)__builtin_amdgcn_readfirstlane(lds0 + (BUF) * 32768 + (2 * w + i_) * 1024)); \
        glds16(vg[i_] + o_, (unsigned)__builtin_amdgcn_readfirstlane(lds0 + (BUF) * 32768 + 16384 + (2 * w + i_) * 1024)); } } while (0)
#define DMA_WAIT_BAR() do { asm volatile("s_waitcnt vmcnt(0)" ::: "memory"); __syncthreads(); } while (0)
    __syncthreads();
    STAGE_T(0, 0); STAGE_T(1, 1);
    asm volatile("s_waitcnt vmcnt(4)" ::: "memory"); __syncthreads();
    for (int t = 0, bi = 0; t < NT; ++t) {
        const bool pf = t + 2 < NT;
        if (bi == 0) { if (pf) STAGE_T(t + 2, 2); if (t <= tmax) attn_tile<0>(L, O, l, qf, krow, fzm, vb); }
        else if (bi == 1) { if (pf) STAGE_T(t + 2, 0); if (t <= tmax) attn_tile<1>(L, O, l, qf, krow, fzm, vb); }
        else { if (pf) STAGE_T(t + 2, 1); if (t <= tmax) attn_tile<2>(L, O, l, qf, krow, fzm, vb); }
        if (pf) asm volatile("s_waitcnt vmcnt(4)" ::: "memory"); else asm volatile("s_waitcnt vmcnt(0)" ::: "memory");
        __syncthreads();
        bi = bi == 2 ? 0 : bi + 1;
    }
#undef STAGE_T
#undef DMA_WAIT_BAR
    l += __shfl_xor(l, 32);
    LAS float* X = (LAS float*)(F.lds + 65536 + g * 16384);
    if (m == 1) { const float i1 = lam / l;
#pragma unroll
        for (int eb = 0; eb < 4; ++eb)
#pragma unroll
            for (int i = 0; i < 16; ++i) X[(eb * 16 + i) * 64 + lane] = O[eb][i] * i1; }
    __syncthreads();
    if (m == 0) { const float i0 = 1.f / l; float ss = 0.f;
#pragma unroll
        for (int eb = 0; eb < 4; ++eb)
#pragma unroll
            for (int i = 0; i < 16; ++i) { const float o = O[eb][i] * i0 - X[(eb * 16 + i) * 64 + lane]; O[eb][i] = o; ss += o * o; }
        ss += __shfl_xor(ss, 32);
        const float rs = rsqrtf(ss * (1.f / 128.f) + EPS) * (1.f - LAM_INIT);
        bf16* orow = OA + (rowbase + q0 + r) * DM + h * 128;
        u32x2 ov[4][4];
#pragma unroll
        for (int eb = 0; eb < 4; ++eb)
#pragma unroll
            for (int g4 = 0; g4 < 4; ++g4) { const int e = 32 * eb + 8 * g4 + 4 * hh; const f32x4 sw = *(const f32x4*)(subw + e);
                ov[eb][g4].x = pk2(O[eb][4 * g4 + 0] * rs * sw.x, O[eb][4 * g4 + 1] * rs * sw.y); ov[eb][g4].y = pk2(O[eb][4 * g4 + 2] * rs * sw.z, O[eb][4 * g4 + 3] * rs * sw.w); }
#pragma unroll
        for (int eb = 0; eb < 4; ++eb)
#pragma unroll
            for (int g4 = 0; g4 < 4; ++g4) *(u32x2*)(orow + 32 * eb + 8 * g4 + 4 * hh) = ov[eb][g4]; }
}

__device__ __forceinline__ void attn_sample_unit(const Frame& F, int b, int h, int sp) {
    const bf16* Qb = (const bf16*)(F.ws + WS_QB); const bf16* Kb = (const bf16*)(F.ws + WS_KB); const bf16* Vb = (const bf16*)(F.ws + WS_VB);
    const float* ck = F.in[2]; const float* cv = F.in[3];
    float* PARTO = (float*)(F.ws + WS_PARTO); float* PARTL = (float*)(F.ws + WS_PARTL);
    int lane = F.lane; asm volatile("" : "+v"(lane)); const int w = F.wave, r = lane & 31, hh = lane >> 5, m = w >> 2, eb = w & 3;
    bf16x8 qf[4];
#pragma unroll
    for (int d0 = 0; d0 < 4; ++d0) qf[d0] = *(const bf16x8*)(Qb + (size_t)(MP + b * DSEQ + r) * DM + h * 128 + m * 64 + 16 * d0 + 8 * hh);
    f32x16 O;
#pragma unroll
    for (int i = 0; i < 16; ++i) O[i] = 0.f;
    float l = 0.f;
    int tid_ = F.tid; asm volatile("" : "+v"(tid_)); const int pr0 = tid_ >> 4, pc = tid_ & 15;
    const int so0 = tile_off(pr0, pc), so1 = tile_off(pr0 + 32, pc);
    const size_t pos0 = (size_t)sp * 2048;
    const float* kg = ck + (((size_t)b * PAST + pos0 + pr0) * NH + h) * 128 + pc * 8; const float* vg = cv + (((size_t)b * PAST + pos0 + pr0) * NH + h) * 128 + pc * 8;
    constexpr size_t RS = (size_t)NH * 128;
    constexpr int NTC = 32;
    const int NT = NTC + (sp == 1 ? 1 : 0);
    f32x4 sk[4], sv[4];
#define LOADC(t) do { const size_t o_ = (size_t)(t) * 64 * RS; sk[0] = *(const f32x4*)(kg + o_); sk[1] = *(const f32x4*)(kg + o_ + 4); sk[2] = *(const f32x4*)(kg + o_ + 32 * RS); sk[3] = *(const f32x4*)(kg + o_ + 32 * RS + 4); \
        sv[0] = *(const f32x4*)(vg + o_); sv[1] = *(const f32x4*)(vg + o_ + 4); sv[2] = *(const f32x4*)(vg + o_ + 32 * RS); sv[3] = *(const f32x4*)(vg + o_ + 32 * RS + 4); } while (0)
#define PK8(a, b_) ((u32x4){pk2((a).x, (a).y), pk2((a).z, (a).w), pk2((b_).x, (b_).y), pk2((b_).z, (b_).w)})
#define STOREC(buf) do { LAS unsigned char* K_ = F.lds + (buf) * 32768; LAS unsigned char* V_ = K_ + 16384; \
        *(LAS u32x4*)(K_ + so0) = PK8(sk[0], sk[1]); *(LAS u32x4*)(K_ + so1) = PK8(sk[2], sk[3]); *(LAS u32x4*)(V_ + so0) = PK8(sv[0], sv[1]); *(LAS u32x4*)(V_ + so1) = PK8(sv[2], sv[3]); } while (0)
    LOADC(0);
    __syncthreads();
    STOREC(0);
    __syncthreads();
    for (int t = 0; t < NT; ++t) {
        const bool more_c = t + 1 < NTC, more_n = (t + 1 == NTC) && (sp == 1);
        u32x4 nk, nv;
        if (more_c) LOADC(t + 1);
        if (more_n) { nk = *(const u32x4*)(Kb + (size_t)(MP + b * DSEQ + pr0) * DM + h * 128 + pc * 8); nv = *(const u32x4*)(Vb + (size_t)(MP + b * DSEQ + pr0) * DM + h * 128 + pc * 8); }
        const LAS unsigned char* KT = F.lds + (t & 1) * 32768; const LAS unsigned char* VT = KT + 16384;
        const int nkb = t < NTC ? 2 : 1;
        {
            f32x16 s0 = qk_block(KT, 0, m, qf, r, hh);
            l += exp_block(s0);
            O = __builtin_amdgcn_mfma_f32_32x32x16_bf16(vfrag(VT, eb, 0, 0, lane), pfrag(s0, 0), O, 0, 0, 0);
            O = __builtin_amdgcn_mfma_f32_32x32x16_bf16(vfrag(VT, eb, 0, 1, lane), pfrag(s0, 1), O, 0, 0, 0);
            if (nkb == 2) {
                f32x16 s1 = qk_block(KT, 1, m, qf, r, hh);
                l += exp_block(s1);
                O = __builtin_amdgcn_mfma_f32_32x32x16_bf16(vfrag(VT, eb, 1, 0, lane), pfrag(s1, 0), O, 0, 0, 0);
                O = __builtin_amdgcn_mfma_f32_32x32x16_bf16(vfrag(VT, eb, 1, 1, lane), pfrag(s1, 1), O, 0, 0, 0);
            }
        }
        if (more_c) STOREC((t + 1) & 1);
        if (more_n) { LAS unsigned char* K_ = F.lds + ((t + 1) & 1) * 32768; LAS unsigned char* V_ = K_ + 16384; *(LAS u32x4*)(K_ + so0) = nk; *(LAS u32x4*)(V_ + so0) = nv; }
        __syncthreads();
    }
#undef LOADC
#undef PK8
#undef STOREC
    l += __shfl_xor(l, 32);
    const size_t pidx = (((size_t)(b * NH + h) * 2 + sp) * 2 + m);
    float* po = PARTO + pidx * 4096;
#pragma unroll
    for (int i = 0; i < 16; ++i) { const int e = 32 * eb + (i & 3) + 8 * (i >> 2) + 4 * hh; po[e * 32 + r] = O[i]; }
    if (eb == 0 && hh == 0) PARTL[pidx * 32 + r] = l;
}

__device__ __forceinline__ void attn_sample_combine(const Frame& F, int b, int h, float lam) {
    const float* PARTO = (const float*)(F.ws + WS_PARTO); const float* PARTL = (const float*)(F.ws + WS_PARTL); bf16* OA = (bf16*)(F.ws + WS_OAB); const float* subw = F.in[14];
    LAS float* red = (LAS float*)F.lds;
    int tid_ = F.tid; asm volatile("" : "+v"(tid_)); const int q = tid_ & 31, eg = tid_ >> 5, e0 = eg * 8;
    const size_t p00 = ((size_t)(b * NH + h) * 2 + 0) * 2, p10 = ((size_t)(b * NH + h) * 2 + 1) * 2;
    const float l0 = PARTL[(p00 + 0) * 32 + q] + PARTL[(p10 + 0) * 32 + q], l1 = PARTL[(p00 + 1) * 32 + q] + PARTL[(p10 + 1) * 32 + q];
    const float i0 = 1.f / l0, i1 = lam / l1;
    float o[8]; float ss = 0.f;
#pragma unroll
    for (int i = 0; i < 8; ++i) { const int e = e0 + i;
        const float a = PARTO[(p00 + 0) * 4096 + e * 32 + q] + PARTO[(p10 + 0) * 4096 + e * 32 + q], c = PARTO[(p00 + 1) * 4096 + e * 32 + q] + PARTO[(p10 + 1) * 4096 + e * 32 + q];
        o[i] = a * i0 - c * i1; ss += o[i] * o[i]; }
    __syncthreads();
    red[q * 16 + eg] = ss;
    __syncthreads();
    float tot = 0.f;
#pragma unroll
    for (int i = 0; i < 16; ++i) tot += red[q * 16 + i];
    const float rs = rsqrtf(tot * (1.f / 128.f) + EPS) * (1.f - LAM_INIT);
    const f32x4 s0 = *(const f32x4*)(subw + e0), s1 = *(const f32x4*)(subw + e0 + 4);
    u32x4 ov; ov.x = pk2(o[0] * rs * s0.x, o[1] * rs * s0.y); ov.y = pk2(o[2] * rs * s0.z, o[3] * rs * s0.w); ov.z = pk2(o[4] * rs * s1.x, o[5] * rs * s1.y); ov.w = pk2(o[6] * rs * s1.z, o[7] * rs * s1.w);
    *(u32x4*)(OA + (size_t)(MP + b * DSEQ + q) * DM + h * 128 + e0) = ov;
}

__device__ __forceinline__ void delta_seq_unit(const Frame& F, int seq, int h) {
    const bf16* QKVC = (const bf16*)(F.ws + WS_QKVC); const float* BETA = (const float*)(F.ws + WS_BETA); const float* GARR = (const float*)(F.ws + WS_G);
    const bf16* DG = (const bf16*)(F.ws + WS_DG); bf16* OB = (bf16*)(F.ws + WS_OAB) + (size_t)MT * DM; const float* dnw = F.in[19];
    const bool sample = seq >= NB; const int L = sample ? DSEQ : SEQ; const size_t row0 = sample ? (size_t)MP + (size_t)(seq - NB) * DSEQ : (size_t)seq * SEQ;
    float* sout = F.out + (sample ? OFF_DS + ((size_t)(seq - NB) * NH + h) * 16384 : OFF_DP + ((size_t)seq * NH + h) * 16384);
    int tid = F.tid; asm volatile("" : "+v"(tid)); const int e = tid & 127, dq = tid >> 7;
    LAS float* Lq = (LAS float*)F.lds; LAS float* Lk = Lq + 4096; LAS float* Lv = Lk + 4096; LAS float* Lb = Lv + 4096; LAS float* Lg = Lb + 32; LAS float* Lqk = Lg + 32;
    LAS float* Lx = Lqk + 32; LAS float* Lo = Lx + 2048;
    float S[32];
    if (sample) { const float* s0 = F.in[4] + ((size_t)(seq - NB) * NH + h) * 16384;
#pragma unroll
        for (int i = 0; i < 32; ++i) S[i] = s0[(32 * dq + i) * 128 + e]; }
    else {
#pragma unroll
        for (int i = 0; i < 32; ++i) S[i] = 0.f; }
    for (int tb = 0; tb < L; tb += 32) {
        __syncthreads();
        { const int f = tid >> 4, c8 = (tid & 15) * 8; const bf16* src = QKVC + (row0 + tb + f) * CONVCH + h * 128 + c8;
#pragma unroll
          for (int part = 0; part < 3; ++part) { const u32x4 v = *(const u32x4*)(src + part * 1024); LAS float* d = (part == 0 ? Lq : part == 1 ? Lk : Lv) + f * 128 + c8;
              *(LAS f32x4*)d = (f32x4){bflo(v.x), bfhi(v.x), bflo(v.y), bfhi(v.y)}; *(LAS f32x4*)(d + 4) = (f32x4){bflo(v.z), bfhi(v.z), bflo(v.w), bfhi(v.w)}; }
          if (tid < 32) { Lb[tid] = BETA[(row0 + tb + tid) * 8 + h]; Lg[tid] = __expf(GARR[(row0 + tb + tid) * 8 + h]); } }
        __syncthreads();
        { const int f = tid >> 4, c8 = (tid & 15) * 8; float a = 0.f;
#pragma unroll
          for (int i = 0; i < 8; ++i) a += Lq[f * 128 + c8 + i] * Lk[f * 128 + c8 + i];
          a += __shfl_xor(a, 1); a += __shfl_xor(a, 2); a += __shfl_xor(a, 4); a += __shfl_xor(a, 8);
          if ((tid & 15) == 0) Lqk[f] = a; }
        __syncthreads();
        for (int f = 0; f < 32; ++f) {
            float pk = 0.f, pq = 0.f;
            const LAS f32x4* kp = (const LAS f32x4*)(Lk + f * 128 + 32 * dq); const LAS f32x4* qp = (const LAS f32x4*)(Lq + f * 128 + 32 * dq);
            float kr[32];
#pragma unroll
            for (int i4 = 0; i4 < 8; ++i4) { const f32x4 kv = kp[i4], qv = qp[i4];
                kr[4 * i4] = kv.x; kr[4 * i4 + 1] = kv.y; kr[4 * i4 + 2] = kv.z; kr[4 * i4 + 3] = kv.w;
                pk += kv.x * S[4 * i4] + kv.y * S[4 * i4 + 1] + kv.z * S[4 * i4 + 2] + kv.w * S[4 * i4 + 3];
                pq += qv.x * S[4 * i4] + qv.y * S[4 * i4 + 1] + qv.z * S[4 * i4 + 2] + qv.w * S[4 * i4 + 3]; }
            LAS float* X = Lx + (f & 1) * 1024;
            X[dq * 128 + e] = pk; X[512 + dq * 128 + e] = pq;
            __syncthreads();
            const float kS = (X[e] + X[128 + e]) + (X[256 + e] + X[384 + e]); const float qS = (X[512 + e] + X[640 + e]) + (X[768 + e] + X[896 + e]);
            const float eg = Lg[f], be = Lb[f];
            const float dl = be * (Lv[f * 128 + e] - eg * kS);
#pragma unroll
            for (int i = 0; i < 32; ++i) S[i] = eg * S[i] + kr[i] * dl;
            if (dq == 0) Lo[f * 128 + e] = eg * qS + Lqk[f] * dl;
        }
        __syncthreads();
        { const int w = F.wave, lane = F.lane;
#pragma unroll
          for (int ff = 0; ff < 4; ++ff) { const int f = 4 * w + ff; const float a = Lo[f * 128 + 2 * lane], c = Lo[f * 128 + 2 * lane + 1];
              const float ss = wave_sum(a * a + c * c); const float rs = rsqrtf(ss * (1.f / 128.f) + EPS);
              const unsigned gw_ = *(const unsigned*)(DG + (row0 + tb + f) * DM + h * 128 + 2 * lane); const float g0 = bflo(gw_), g1 = bfhi(gw_);
              const float o0 = a * rs * dnw[2 * lane] * (g0 * sigmoidf_(g0)), o1 = c * rs * dnw[2 * lane + 1] * (g1 * sigmoidf_(g1));
              *(unsigned*)(OB + (row0 + tb + f) * DM + h * 128 + 2 * lane) = pk2(o0, o1); } }
    }
#pragma unroll
    for (int i = 0; i < 32; ++i) sout[(32 * dq + i) * 128 + e] = S[i];
}

constexpr size_t WS_DW = 910 * MiB;
constexpr size_t WS_DAL = 976 * MiB;
constexpr size_t WS_DEG = 1009 * MiB;
constexpr size_t WS_DUT_P = 455 * MiB;
constexpr size_t WS_DUT_S = 1012 * MiB;
constexpr size_t WS_END2 = 1014 * MiB;
static_assert(WS_DUT_P >= WS_OAB + 130 * MiB && WS_DUT_P + 64 * MiB <= WS_QKVC && WS_DW >= WS_GB + 65 * MiB, "delta workspace map");
__device__ __forceinline__ bf16* dut_ptr(unsigned char* ws, size_t ch) { return (bf16*)(ws + (ch < 4096 ? WS_DUT_P + ch * 16384 : WS_DUT_S + (ch - 4096) * 16384)); }
constexpr int NCH = 528;


template <int I> struct SolveRow {
    static __device__ __forceinline__ void run(f32x2 (&x)[64], const f32x16 (&Mt)[3], float cf) {
        f32x2 a0 = {0.f, 0.f}, a1 = {0.f, 0.f}, a2 = {0.f, 0.f}, a3 = {0.f, 0.f};
        constexpr int q = (I & 3) + 4 * ((I >> 3) & 3), lh = 32 * ((I >> 2) & 1);
#pragma unroll
        for (int j = 0; j < I; ++j) {
            const int t3 = (I >> 5) == 0 ? 0 : ((j >> 5) == 0 ? 1 : 2);
            const float mv = Mt[t3][q]; const float m = __int_as_float(__builtin_amdgcn_readlane(__float_as_int(mv), (j & 31) + lh));
            if ((j & 3) == 0) a0 += m * x[j]; else if ((j & 3) == 1) a1 += m * x[j]; else if ((j & 3) == 2) a2 += m * x[j]; else a3 += m * x[j];
        }
        const float ci = __int_as_float(__builtin_amdgcn_readlane(__float_as_int(cf), I));
        x[I] = ci * x[I] - ((a0 + a1) + (a2 + a3));
        SolveRow<I + 1>::run(x, Mt, cf);
    }
};
template <> struct SolveRow<64> { static __device__ __forceinline__ void run(f32x2 (&)[64], const f32x16 (&)[3], float) {} };

__device__ __forceinline__ void delta_chunk_unit(const Frame& F, int cu) {
    bf16* DW = (bf16*)(F.ws + WS_DW); bf16* DAL = (bf16*)(F.ws + WS_DAL); float* DEG = (float*)(F.ws + WS_DEG);
    const bf16* QKVC = (const bf16*)(F.ws + WS_QKVC); const float* BETA = (const float*)(F.ws + WS_BETA); const float* GARR = (const float*)(F.ws + WS_G);
    int lane = F.lane; asm volatile("" : "+v"(lane)); const int h = F.wave, r = lane & 31, hh = lane >> 5;
    const bool sample = cu >= 512; const size_t row0 = sample ? (size_t)MP + (size_t)(cu - 512) * 32 : (size_t)cu * 64; const int nvalid = sample ? 32 : 64;
    const size_t ch = (size_t)cu * 8 + h;
    LAS float* tabG = (LAS float*)(F.lds + h * 1024); LAS float* tabB = tabG + 64;
    float gc = lane < nvalid ? GARR[(row0 + lane) * 8 + h] : 0.f; const float be = lane < nvalid ? BETA[(row0 + lane) * 8 + h] : 0.f;
#pragma unroll
    for (int o = 1; o < 64; o <<= 1) { const float t = __shfl_up(gc, o); if (lane >= o) gc += t; }
    const float glast = __shfl(gc, 63);
    tabG[lane] = gc; tabB[lane] = be;
    DEG[ch * 128 + lane] = __expf(gc); DEG[ch * 128 + 64 + lane] = __expf(glast - gc);
    bf16x8 kf[2][8];
#pragma unroll
    for (int ib = 0; ib < 2; ++ib)
#pragma unroll
        for (int d0 = 0; d0 < 8; ++d0) { if (sample && ib == 1) kf[ib][d0] = (bf16x8){0, 0, 0, 0, 0, 0, 0, 0}; else kf[ib][d0] = *(const bf16x8*)(QKVC + (row0 + 32 * ib + r) * CONVCH + 1024 + h * 128 + 16 * d0 + 8 * hh); }
    const float gj0 = __shfl(gc, r), gj1 = __shfl(gc, 32 + r);
    LDS_WAIT();
    f32x16 Mt[3];
#pragma unroll
    for (int t3 = 0; t3 < 3; ++t3) { const int ib = t3 == 0 ? 0 : 1, jb = t3 == 2 ? 1 : 0;
        f32x16 acc;
#pragma unroll
        for (int i = 0; i < 16; ++i) acc[i] = 0.f;
#pragma unroll
        for (int d0 = 0; d0 < 8; ++d0) acc = __builtin_amdgcn_mfma_f32_32x32x16_bf16(kf[ib][d0], kf[jb][d0], acc, 0, 0, 0);
        const float gj = jb ? gj1 : gj0;
#pragma unroll
        for (int q = 0; q < 16; ++q) { const int i = 32 * ib + (q & 3) + 8 * (q >> 2) + 4 * hh; const float d = fminf(tabG[i] - gj, 0.f);
            Mt[t3][q] = tabB[i] * acc[q] * __expf(d); }
    }
#pragma unroll
    for (int ib = 0; ib < 2; ++ib) {
        bf16x8 qf[8];
#pragma unroll
        for (int d0 = 0; d0 < 8; ++d0) { if (sample && ib == 1) qf[d0] = (bf16x8){0, 0, 0, 0, 0, 0, 0, 0}; else qf[d0] = *(const bf16x8*)(QKVC + (row0 + 32 * ib + r) * CONVCH + h * 128 + 16 * d0 + 8 * hh); }
#pragma unroll
        for (int jb = 0; jb <= ib; ++jb) {
            f32x16 acc;
#pragma unroll
            for (int i = 0; i < 16; ++i) acc[i] = 0.f;
#pragma unroll
            for (int d0 = 0; d0 < 8; ++d0) acc = __builtin_amdgcn_mfma_f32_32x32x16_bf16(qf[d0], kf[jb][d0], acc, 0, 0, 0);
            const float gj = jb ? gj1 : gj0; const int j = 32 * jb + r;
            bf16* ad = DAL + ch * 4096 + j; asm volatile("" : "+v"(ad));
#pragma unroll
            for (int q = 0; q < 16; ++q) { const int i = 32 * ib + (q & 3) + 8 * (q >> 2) + 4 * hh; const float d = fminf(tabG[i] - gj, 0.f);
                const float a = i >= j ? acc[q] * __expf(d) : 0.f;
                ad[i * 64] = (bf16)(pk2(a, 0.f) & 0xffffu); }
            asm volatile("" ::: "memory");
        }
    }
    const float cu_ = be, cw_ = be * __expf(gc);
#pragma unroll 1
    for (int p = 0; p < 2; ++p) {
        const bool isw = p == 1;
        const bf16* src = QKVC + row0 * CONVCH + (isw ? 1024 : 2048) + h * 128 + lane; asm volatile("" : "+v"(src));
        float cf = isw ? cw_ : cu_; asm volatile("" : "+v"(cf));
        f32x2 x[64];
#pragma unroll
        for (int i = 0; i < 64; ++i) { const int ic = (sample && i >= 32) ? 31 : i; x[i].x = bf1(src[(size_t)ic * CONVCH]); x[i].y = bf1(src[(size_t)ic * CONVCH + 64]); if ((i & 7) == 7) asm volatile("" ::: "memory"); }
        SolveRow<0>::run(x, Mt, cf);
        if (!isw) { bf16* d0_ = dut_ptr(F.ws, ch) + (size_t)lane * 64; asm volatile("" : "+v"(d0_)); bf16* d1_ = d0_ + 64 * 64;
#pragma unroll
            for (int i8 = 0; i8 < 8; ++i8) { u32x4 o; o.x = pk2(x[8 * i8].x, x[8 * i8 + 1].x); o.y = pk2(x[8 * i8 + 2].x, x[8 * i8 + 3].x); o.z = pk2(x[8 * i8 + 4].x, x[8 * i8 + 5].x); o.w = pk2(x[8 * i8 + 6].x, x[8 * i8 + 7].x); *(u32x4*)(d0_ + 8 * i8) = o;
                o.x = pk2(x[8 * i8].y, x[8 * i8 + 1].y); o.y = pk2(x[8 * i8 + 2].y, x[8 * i8 + 3].y); o.z = pk2(x[8 * i8 + 4].y, x[8 * i8 + 5].y); o.w = pk2(x[8 * i8 + 6].y, x[8 * i8 + 7].y); *(u32x4*)(d1_ + 8 * i8) = o; } }
        else { bf16* dst = DW + ch * 8192 + lane; asm volatile("" : "+v"(dst));
#pragma unroll
            for (int i = 0; i < 64; ++i) { dst[i * 128] = (bf16)(pk2(x[i].x, 0.f) & 0xffffu); dst[i * 128 + 64] = (bf16)(pk2(x[i].y, 0.f) & 0xffffu); if ((i & 7) == 7) asm volatile("" ::: "memory"); } }
    }
}

__device__ __forceinline__ int vt_off(int e, int chunk) { return 128 * e + 16 * (chunk ^ ((e >> 1) & 7)); }
__device__ __forceinline__ void delta_scan_unit(const Frame& F, int seq, int h) {
    const bf16* DW = (const bf16*)(F.ws + WS_DW); const bf16* DAL = (const bf16*)(F.ws + WS_DAL); const float* DEG = (const float*)(F.ws + WS_DEG);
    const bf16* QKVC = (const bf16*)(F.ws + WS_QKVC); const bf16* DG = (const bf16*)(F.ws + WS_DG); bf16* OB = (bf16*)(F.ws + WS_OAB) + (size_t)MT * DM; const float* dnw = F.in[19];
    int tid = F.tid; asm volatile("" : "+v"(tid)); const int lane = tid & 63, w = F.wave, r = lane & 31, hh = lane >> 5;
    const bool sample = seq >= NB; const int nsteps = sample ? 1 : 32; const int nvalid = sample ? 32 : 64;
    const size_t rowbase = sample ? (size_t)MP + (size_t)(seq - NB) * DSEQ : (size_t)seq * SEQ;
    const size_t ch0 = sample ? (size_t)(512 + (seq - NB)) * 8 + h : (size_t)(seq * 32) * 8 + h;
    float* sout = F.out + (sample ? OFF_DS + ((size_t)(seq - NB) * NH + h) * 16384 : OFF_DP + ((size_t)seq * NH + h) * 16384);
    LAS unsigned char* ST = F.lds; LAS unsigned char* VT = F.lds + 32768; LAS unsigned char* VTP = F.lds + 49152; LAS unsigned char* KI = F.lds + 65536;
    LAS float* Ost = (LAS float*)(F.lds + 98304); LAS float* tab0 = (LAS float*)(F.lds + 131072);
    const int ib = w & 1, ebp = w >> 1, dkb = w >> 1, eb0 = 2 * (w & 1);
    f32x16 S[2];
    if (sample) { const float* s0 = F.in[4] + ((size_t)(seq - NB) * NH + h) * 16384;
#pragma unroll
        for (int t = 0; t < 2; ++t)
#pragma unroll
            for (int q = 0; q < 16; ++q) S[t][q] = s0[(size_t)(32 * dkb + (q & 3) + 8 * (q >> 2) + 4 * hh) * 128 + 32 * (eb0 + t) + r]; }
    else {
#pragma unroll
        for (int t = 0; t < 2; ++t)
#pragma unroll
            for (int q = 0; q < 16; ++q) S[t][q] = 0.f; }
    __syncthreads();
#define WRITE_ST() do { _Pragma("unroll") for (int t_ = 0; t_ < 2; ++t_) { const int e_ = 32 * (eb0 + t_) + r; _Pragma("unroll") for (int g4 = 0; g4 < 4; ++g4) { \
        u32x2 o_; o_.x = pk2(S[t_][4 * g4], S[t_][4 * g4 + 1]); o_.y = pk2(S[t_][4 * g4 + 2], S[t_][4 * g4 + 3]); \
        *(LAS u32x2*)(ST + tile_off(e_, 4 * dkb + g4) + 8 * hh) = o_; } } } while (0)
    WRITE_ST();
    const int pr0 = tid >> 4, pc = tid & 15; const int so0 = tile_off(pr0, pc), so1 = tile_off(pr0 + 32, pc);
    const bf16* kbase = QKVC + (rowbase + pr0) * CONVCH + 1024 + h * 128 + pc * 8;
    u32x4 kst[2];
    kst[0] = *(const u32x4*)kbase; kst[1] = (sample) ? (u32x4){0u, 0u, 0u, 0u} : *(const u32x4*)(kbase + (size_t)32 * CONVCH);
    *(LAS u32x4*)(KI + so0) = kst[0]; *(LAS u32x4*)(KI + so1) = kst[1];
    int vb[1][2];
    { const int gsel = (lane >> 4) & 1, q = (lane >> 2) & 3, p = lane & 3;
#pragma unroll
      for (int hl = 0; hl < 2; ++hl) { const int row = 4 * hh + q + 8 * hl; vb[0][hl] = 256 * row + 16 * ((4 * dkb + 2 * gsel + (p >> 1)) ^ swz_f(row)) + 8 * (p & 1); } }
    const int e1 = 32 * ebp + r;
    const int st_row = 256 * e1, st_fz = swz_f(e1) ^ hh;
    const bool zr = sample && ib == 1;
    bf16x8 wf[8], qf[8], af[4]; u32x2 uu[4]; float tabv = 0.f;
#define LOAD_WQ(n_) do { const size_t ch_ = ch0 + 8 * (size_t)(n_); const size_t rw_ = rowbase + (size_t)(n_) * 64; _Pragma("unroll") for (int d0 = 0; d0 < 8; ++d0) { \
        wf[d0] = *(const bf16x8*)(DW + ch_ * 8192 + (size_t)(32 * ib + r) * 128 + 16 * d0 + 8 * hh); \
        qf[d0] = zr ? (bf16x8){0, 0, 0, 0, 0, 0, 0, 0} : *(const bf16x8*)(QKVC + (rw_ + 32 * ib + r) * CONVCH + h * 128 + 16 * d0 + 8 * hh); } } while (0)
#define LOAD_U(n_) do { const bf16* up_ = dut_ptr(F.ws, ch0 + 8 * (size_t)(n_)) + (size_t)e1 * 64 + 32 * ib + 4 * hh; _Pragma("unroll") for (int g4 = 0; g4 < 4; ++g4) uu[g4] = *(const u32x2*)(up_ + 8 * g4); } while (0)
#define LOAD_A(n_) do { const size_t ch_ = ch0 + 8 * (size_t)(n_); _Pragma("unroll") for (int jb = 0; jb < 2; ++jb) _Pragma("unroll") for (int s_ = 0; s_ < 2; ++s_) { if (jb <= ib) \
        af[jb * 2 + s_] = *(const bf16x8*)(DAL + ch_ * 4096 + (size_t)(32 * ib + r) * 64 + 32 * jb + 16 * s_ + 8 * hh); } } while (0)
#define LOAD_DG(n_) do { const size_t rw_ = rowbase + (size_t)(n_) * 64; _Pragma("unroll") for (int ff = 0; ff < 8; ++ff) { const int f_ = 8 * w + ff; \
        dgv[ff] = (f_ < nvalid) ? *(const unsigned*)(DG + (rw_ + f_) * DM + h * 128 + 2 * lane) : 0u; } } while (0)
#define NORM_STORE(n_) do { const size_t rw_ = rowbase + (size_t)(n_) * 64; unsigned gwv_[8]; \
        _Pragma("unroll") for (int ff = 0; ff < 8; ++ff) { const int f_ = 8 * w + ff; gwv_[ff] = (f_ < nvalid) ? *(const unsigned*)(DG + (rw_ + f_) * DM + h * 128 + 2 * lane) : 0u; } \
        const float dn0_ = dnw[2 * lane], dn1_ = dnw[2 * lane + 1]; \
        asm volatile("s_waitcnt vmcnt(0)" ::: "memory"); _Pragma("unroll") for (int ff = 0; ff < 8; ++ff) asm volatile("" : "+v"(gwv_[ff])); \
        _Pragma("unroll") for (int ff = 0; ff < 8; ++ff) { const int f_ = 8 * w + ff; \
        const float a_ = Ost[f_ * 128 + 2 * lane], c_ = Ost[f_ * 128 + 2 * lane + 1]; const float ss_ = wave_sum(a_ * a_ + c_ * c_); const float rs_ = rsqrtf(ss_ * (1.f / 128.f) + EPS); \
        const float g0_ = bflo(gwv_[ff]), g1_ = bfhi(gwv_[ff]); \
        if (f_ < nvalid) *(unsigned*)(OB + (rw_ + f_) * DM + h * 128 + 2 * lane) = pk2(a_ * rs_ * dn0_ * (g0_ * sigmoidf_(g0_)), c_ * rs_ * dn1_ * (g1_ * sigmoidf_(g1_))); } } while (0)
    LOAD_WQ(0); LOAD_U(0); LOAD_A(0);
    if (tid < 128) tabv = DEG[ch0 * 128 + tid];
    for (int n = 0; n < nsteps; ++n) {
        const bool more = n + 1 < nsteps;
        LAS float* tabEG = tab0 + (n & 1) * 128; LAS float* tabET = tabEG + 64;
        if (tid < 128) tabEG[tid] = tabv;
        if (more) { const bf16* kn = kbase + (size_t)(n + 1) * 64 * CONVCH; kst[0] = *(const u32x4*)kn; kst[1] = *(const u32x4*)(kn + (size_t)32 * CONVCH); if (tid < 128) tabv = DEG[(ch0 + 8 * (size_t)(n + 1)) * 128 + tid]; }
        __syncthreads();
        if (n > 0) NORM_STORE(n - 1);
        f32x16 ws_, qs_;
#pragma unroll
        for (int q = 0; q < 16; ++q) { ws_[q] = 0.f; qs_[q] = 0.f; }
#pragma unroll
        for (int d0 = 0; d0 < 8; ++d0) { const bf16x8 sf = *(const LAS bf16x8*)(ST + st_row + 16 * ((2 * d0) ^ st_fz));
            ws_ = __builtin_amdgcn_mfma_f32_32x32x16_bf16(wf[d0], sf, ws_, 0, 0, 0); qs_ = __builtin_amdgcn_mfma_f32_32x32x16_bf16(qf[d0], sf, qs_, 0, 0, 0); }
        if (more) LOAD_WQ(n + 1);
#pragma unroll
        for (int g4 = 0; g4 < 4; ++g4) { const int i0 = 32 * ib + 8 * g4 + 4 * hh;
            const float v0 = bflo(uu[g4].x) - ws_[4 * g4], v1 = bfhi(uu[g4].x) - ws_[4 * g4 + 1], v2 = bflo(uu[g4].y) - ws_[4 * g4 + 2], v3 = bfhi(uu[g4].y) - ws_[4 * g4 + 3];
            const f32x4 et = *(const LAS f32x4*)(tabET + i0), eg = *(const LAS f32x4*)(tabEG + i0);
            u32x2 a, b; a.x = pk2(v0, v1); a.y = pk2(v2, v3); b.x = pk2(v0 * et.x, v1 * et.y); b.y = pk2(v2 * et.z, v3 * et.w);
            const int off = vt_off(e1, 4 * ib + g4) + 8 * hh;
            *(LAS u32x2*)(VT + off) = a; *(LAS u32x2*)(VTP + off) = b;
            qs_[4 * g4] *= eg.x; qs_[4 * g4 + 1] *= eg.y; qs_[4 * g4 + 2] *= eg.z; qs_[4 * g4 + 3] *= eg.w; }
        if (more) { LOAD_U(n + 1); LAS unsigned char* KN = KI + ((n + 1) & 1) * 16384; *(LAS u32x4*)(KN + so0) = kst[0]; *(LAS u32x4*)(KN + so1) = kst[1]; }
        __syncthreads();
#pragma unroll
        for (int jb = 0; jb < 2; ++jb) { if (jb <= ib) {
#pragma unroll
            for (int s = 0; s < 2; ++s) { const bf16x8 vf = *(const LAS bf16x8*)(VT + vt_off(e1, 4 * jb + 2 * s + hh));
                qs_ = __builtin_amdgcn_mfma_f32_32x32x16_bf16(af[jb * 2 + s], vf, qs_, 0, 0, 0); } } }
        if (more) LOAD_A(n + 1);
#pragma unroll
        for (int q = 0; q < 16; ++q) Ost[(32 * ib + (q & 3) + 8 * (q >> 2) + 4 * hh) * 128 + e1] = qs_[q];
        { const float gt = tabEG[63]; const LAS unsigned char* KC = KI + (n & 1) * 16384;
#pragma unroll
          for (int t = 0; t < 2; ++t) { const int e = 32 * (eb0 + t) + r;
#pragma unroll
              for (int q = 0; q < 16; ++q) S[t][q] *= gt;
#pragma unroll
              for (int kb = 0; kb < 2; ++kb)
#pragma unroll
                  for (int s = 0; s < 2; ++s) {
                      const s16x4 lo = vtr(KC + vb[0][0] + 8192 * kb + 4096 * s), hi = vtr(KC + vb[0][1] + 8192 * kb + 4096 * s);
                      const u32x2 b0 = *(const LAS u32x2*)(VTP + vt_off(e, 4 * kb + 2 * s) + 8 * hh), b1 = *(const LAS u32x2*)(VTP + vt_off(e, 4 * kb + 2 * s + 1) + 8 * hh);
                      const u32x4 bb = {b0.x, b0.y, b1.x, b1.y};
                      S[t] = __builtin_amdgcn_mfma_f32_32x32x16_bf16((bf16x8){lo[0], lo[1], lo[2], lo[3], hi[0], hi[1], hi[2], hi[3]}, __builtin_bit_cast(bf16x8, bb), S[t], 0, 0, 0); } } }
        WRITE_ST();
    }
#undef WRITE_ST
    __syncthreads();
    NORM_STORE(nsteps - 1);
#undef LOAD_WQ
#undef LOAD_U
#undef LOAD_A
#undef LOAD_DG
#undef NORM_STORE
#pragma unroll
    for (int t = 0; t < 2; ++t)
#pragma unroll
        for (int q = 0; q < 16; ++q) sout[(size_t)(32 * dkb + (q & 3) + 8 * (q >> 2) + 4 * hh) * 128 + 32 * (eb0 + t) + r] = S[t][q];
}
#define LAS_ LAS
#define XB_TMO      128
#define XB_XCNT(j)  (256  + 64 * (j))
#define XB_XSUB(j)  (1280 + 64 * (j))
#define XB_XGEN(j)  (2304 + 64 * (j))
#define XB_TOP      3328
#define XB_TOPGEN   3392
#define XCD_BAR_WORDS 3456
#define XB_SPIN_CAP (1u << 18)

__device__ __forceinline__ unsigned xb_ld(unsigned* p)              { return __hip_atomic_load(p, __ATOMIC_RELAXED, __HIP_MEMORY_SCOPE_AGENT); }
__device__ __forceinline__ unsigned xb_add(unsigned* p, unsigned v) { return __hip_atomic_fetch_add(p, v, __ATOMIC_RELAXED, __HIP_MEMORY_SCOPE_AGENT); }
__device__ __forceinline__ unsigned xb_xcc_id() { return (unsigned)__builtin_amdgcn_s_getreg((3 << 11) | 20) & 0xFu; }
#define XB_SPIN(cond, bar) do { unsigned _sp = 0; while (cond) { __builtin_amdgcn_s_sleep(1); \
    if ((++_sp & 255u) == 0u) { if (xb_ld(&(bar)[XB_TMO])) break; if (_sp > XB_SPIN_CAP) { atomicAdd(&(bar)[XB_TMO], 1u); break; } } } } while (0)

struct XcdBarrier {
    unsigned* bar; unsigned x; int wave;
    volatile LAS unsigned* st;
};

__device__ __forceinline__ bool xb_leader(int wave) { return wave == 0 && fresh_lane_id() == 0; }
__device__ __forceinline__ XcdBarrier xcd_barrier_post(unsigned* bar, volatile LAS unsigned* st, int wave) {
    XcdBarrier b; b.bar = bar; b.x = xb_xcc_id(); b.st = st; b.wave = wave;
    if (xb_leader(wave)) (void)xb_add(&bar[XB_XCNT(b.x)], 1u);
    return b;
}
__device__ __forceinline__ void xcd_barrier_complete(unsigned* bar, unsigned x, unsigned& nloc, unsigned& nx) {
    const unsigned G = gridDim.x * gridDim.y * gridDim.z;
    unsigned sum, cnt, mine, sp = 0u;
    for (;;) {
        sum = 0u; cnt = 0u; mine = 0u;
#pragma unroll
        for (unsigned j = 0; j < 16; ++j) { const unsigned c = xb_ld(&bar[XB_XCNT(j)]); sum += c; cnt += (c > 0u) ? 1u : 0u; mine = (j == x) ? c : mine; }
        if (sum == G) break;
        __builtin_amdgcn_s_sleep(1);
        if ((++sp & 255u) == 0u) { if (xb_ld(&bar[XB_TMO])) break; if (sp > XB_SPIN_CAP) { atomicAdd(&bar[XB_TMO], 1u); break; } }
    }
    nloc = mine > 0u ? mine : 1u; nx = cnt > 0u ? cnt : 1u;
}

__device__ __forceinline__ void xcd_barrier(const XcdBarrier& b) {
    asm volatile("s_waitcnt vmcnt(0)" ::: "memory");
    __syncthreads();
    if (xb_leader(b.wave)) {
        unsigned* bar = b.bar;
        __builtin_amdgcn_s_waitcnt(0);
        unsigned nloc = b.st[0], nx = b.st[1];
        if (nloc == 0u) { xcd_barrier_complete(bar, b.x, nloc, nx); b.st[0] = nloc; b.st[1] = nx; }
        const unsigned old = xb_add(&bar[XB_XSUB(b.x)], 1u);
        const unsigned gen = old / nloc;
        if (old + 1u == (gen + 1u) * nloc) {
            __builtin_amdgcn_fence(__ATOMIC_RELEASE, "agent");
            asm volatile("s_waitcnt vmcnt(0)" ::: "memory");
            const unsigned og = xb_add(&bar[XB_TOP], 1u);
            const unsigned tg = og / nx;
            if (og + 1u == (tg + 1u) * nx) xb_add(&bar[XB_TOPGEN], 1u);
            else XB_SPIN(xb_ld(&bar[XB_TOPGEN]) == tg, bar);
            __builtin_amdgcn_fence(__ATOMIC_ACQUIRE, "agent");
            xb_add(&bar[XB_XGEN(b.x)], 1u);
            asm volatile("s_waitcnt vmcnt(0)" ::: "memory");
        } else {
            XB_SPIN(xb_ld(&bar[XB_XGEN(b.x)]) == gen, bar);
            __builtin_amdgcn_fence(__ATOMIC_ACQUIRE, "agent");
            asm volatile("s_waitcnt vmcnt(0)" ::: "memory");
        }
    }
    __syncthreads();
}

#ifndef PROBE_DUP
#define PROBE_DUP -1
#endif
#ifndef USE_XCDBAR
#define USE_XCDBAR 1
#endif
constexpr int CW_BAR = 1024, CW_Q4 = 192;
constexpr int N_PHASES = 9;
__device__ __forceinline__ int next_unit(const Frame& F, unsigned* ctr) {
    volatile LAS int* slot = (volatile LAS int*)(F.lds + LDS_BYTES - 16);
    __syncthreads();
    if (F.tid == 0) *slot = (int)__hip_atomic_fetch_add(ctr, 1u, __ATOMIC_RELAXED, __HIP_MEMORY_SCOPE_AGENT);
    __syncthreads();
    return *slot;
}

template <int PH> __device__ __forceinline__ void run_phase(const Frame& F0, int rep = 0) {
    Frame F = F0; F.lane = fresh_lane_id(); asm volatile("" : "+v"(F.lane)); F.tid = F.wave * 64 + F.lane;
    unsigned char* ws = F.ws;
    if constexpr (PH == 0) { p0_prologue(F); }
    if constexpr (PH == 1) {
        pg8::Gemm g{(const bf16*)(ws + WS_XN), (const bf16*)(ws + WS_WIN), MT, NZ, DM}; pg8::StaticOrder S; S.init(MT, NZ, F.G, F.bid);
        pg8::EpiZ E{ws, F.out};
        pg8::gemm_phase<pg8::EpiZ, pg8::StaticOrder, true, true>(F.lds, g, S, E, F.wave);
    }
    if constexpr (PH == 2) {
        unsigned* ctr = (unsigned*)(ws + WS_CTL) + CW_Q2 + 16 * rep;
        for (;;) { const int u = next_unit(F, ctr); if (u >= 256 + 780) break;
            if (u < 256) attn_sample_unit(F, u >> 4, (u >> 1) & 7, u & 1);
            else conv_task(F, (u - 256) * 8 + F.wave); }
    }
    if constexpr (PH == 3) {
        unsigned* ctr = (unsigned*)(ws + WS_CTL) + CW_Q3 + 16 * rep;
        for (;;) { const int u = next_unit(F, ctr); if (u >= NCH) break; delta_chunk_unit(F, u); }
    }
    if constexpr (PH == 8) {
        unsigned* ctr = (unsigned*)(ws + WS_CTL) + CW_Q4 + 16 * rep;
        const float lam = lambda_of(F);
#ifndef PROBE_P8
#define PROBE_P8 0
#endif
        constexpr int NSC = PROBE_P8 == 1 ? 256 : 128, NAT = PROBE_P8 == 2 ? 4096 : 2048;
        for (;;) { const int u = next_unit(F, ctr); if (u >= NSC + NAT + 128 + 128) break;
            if (u < NSC) delta_scan_unit(F, (u & 127) >> 3, u & 7);
            else if (u < NSC + NAT) { const int a = (u - NSC) & 2047; attn_prompt_unit(F, a & 15, (a >> 4) & 7, 15 - (a >> 7), lam); }
            else if (u < NSC + NAT + 128) { const int a = u - NSC - NAT; delta_scan_unit(F, NB + (a >> 3), a & 7); }
            else { const int a = u - NSC - NAT - 128; attn_sample_combine(F, a >> 3, a & 7, lam); } }
    }
    if constexpr (PH == 4) {
        pg8::Gemm g{(const bf16*)(ws + WS_OAB), (const bf16*)(ws + WS_WAB), 2 * MT, 2048, DM}; pg8::PairOrder S{F.G, F.bid};
        pg8::EpiAB E{ws, F.out + OFF_Y};
        pg8::gemm_phase<pg8::EpiAB, pg8::PairOrder, true, true>(F.lds, g, S, E, F.wave);
    }
    if constexpr (PH == 5) {
        pg8::Gemm g{(const bf16*)(ws + WS_MERGED), (const bf16*)(ws + WS_WO), MT, DM, DM}; pg8::StaticOrder S; S.init(MT, DM, F.G, F.bid);
        pg8::EpiOut E{F.in[0], F.in[1], F.out + OFF_Y, (bf16*)(ws + WS_X1B), (float*)(ws + WS_RSS)};
        pg8::gemm_phase<pg8::EpiOut, pg8::StaticOrder, true, true>(F.lds, g, S, E, F.wave);
    }
    if constexpr (PH == 6) {
        pg8::Gemm g{(const bf16*)(ws + WS_X1B), (const bf16*)(ws + WS_WGU), MT, 2 * DFF, DM}; pg8::StaticOrder S; S.init(MT, 2 * DFF, F.G, F.bid);
        pg8::EpiGU E{(const float*)(ws + WS_RSS), (bf16*)(ws + WS_ACT)};
        pg8::gemm_phase<pg8::EpiGU, pg8::StaticOrder, true, true>(F.lds, g, S, E, F.wave);
    }
    if constexpr (PH == 7) {
        pg8::Gemm g{(const bf16*)(ws + WS_ACT), (const bf16*)(ws + WS_WD), MT, DM, DFF}; pg8::StaticOrder S; S.init(MT, DM, F.G, F.bid);
        pg8::EpiDown E{F.out + OFF_Y};
        pg8::gemm_phase<pg8::EpiDown, pg8::StaticOrder, true, true>(F.lds, g, S, E, F.wave);
    }
}

__device__ __forceinline__ Frame make_frame(const Args& a, unsigned char* lds) {
    Frame F; F.lds = (LAS unsigned char*)lds; F.ws = a.ws; F.out = a.out; F.in = a.in;
    F.wave = __builtin_amdgcn_readfirstlane((int)threadIdx.x >> 6); F.lane = fresh_lane_id(); F.tid = F.wave * 64 + F.lane; F.G = gridDim.x; F.bid = blockIdx.x;
    return F;
}

#if MEGA
__global__ void __launch_bounds__(NTHREADS, 2) mega_kernel(Args a) {
    extern __shared__ __attribute__((aligned(16))) unsigned char lds[];
    cg::grid_group grid = cg::this_grid();
    const Frame F = make_frame(a, lds);
#if USE_XCDBAR
    if (F.tid < 8) ((LAS unsigned*)(F.lds + LDS_BYTES - 64))[F.tid] = 0u;
    __syncthreads();
    XcdBarrier bar = xcd_barrier_post((unsigned*)(a.ws + WS_CTL) + CW_BAR, (volatile LAS unsigned*)(F.lds + LDS_BYTES - 64), F.wave);
#define SEAM() xcd_barrier(bar)
#else
#define SEAM() grid.sync()
#endif
#define PHASE(k) do { run_phase<k>(F); if (PROBE_DUP == k) { SEAM(); run_phase<k>(F, 1); } } while (0)
    PHASE(0); grid.sync();
    PHASE(1); SEAM();
    PHASE(2); SEAM();
    PHASE(3); SEAM();
    PHASE(8); SEAM();
    PHASE(4); SEAM();
    PHASE(5); SEAM();
    PHASE(6); SEAM();
    run_phase<7>(F);
#undef PHASE
#undef SEAM
}
#else
template <int PH> __global__ void __launch_bounds__(NTHREADS, 2) phase_kernel(Args a) {
    extern __shared__ __attribute__((aligned(16))) unsigned char lds[];
    const Frame F = make_frame(a, lds);
    run_phase<PH>(F);
}
#endif

extern "C" void kernel_launch(void* const* d_in, const int* in_sizes, int n_in, void* d_out, int out_size, void* d_ws, size_t ws_size, hipStream_t stream) {
    static int grid = 0;
    if (grid == 0) {
        if (n_in != 25 || out_size != (int)OUT_TOTAL || ws_size < WS_END2) { fprintf(stderr, "kernel_launch: unexpected shapes n_in %d out %d ws %zu\n", n_in, out_size, ws_size); grid = -1; return; }
        int dev = 0, cus = 0;
        hipGetDevice(&dev); hipDeviceGetAttribute(&cus, hipDeviceAttributeMultiprocessorCount, dev);
#if MEGA
        hipFuncSetAttribute((const void*)mega_kernel, hipFuncAttributeMaxDynamicSharedMemorySize, LDS_BYTES);
        int per_cu = 0; hipOccupancyMaxActiveBlocksPerMultiprocessor(&per_cu, (const void*)mega_kernel, NTHREADS, LDS_BYTES);
        if (per_cu < 1) { fprintf(stderr, "kernel_launch: occupancy query says %d blocks per CU\n", per_cu); per_cu = 1; }
#else
        hipFuncSetAttribute((const void*)phase_kernel<0>, hipFuncAttributeMaxDynamicSharedMemorySize, LDS_BYTES);
        hipFuncSetAttribute((const void*)phase_kernel<1>, hipFuncAttributeMaxDynamicSharedMemorySize, LDS_BYTES);
        hipFuncSetAttribute((const void*)phase_kernel<2>, hipFuncAttributeMaxDynamicSharedMemorySize, LDS_BYTES);
        hipFuncSetAttribute((const void*)phase_kernel<3>, hipFuncAttributeMaxDynamicSharedMemorySize, LDS_BYTES);
        hipFuncSetAttribute((const void*)phase_kernel<4>, hipFuncAttributeMaxDynamicSharedMemorySize, LDS_BYTES);
        hipFuncSetAttribute((const void*)phase_kernel<5>, hipFuncAttributeMaxDynamicSharedMemorySize, LDS_BYTES);
        hipFuncSetAttribute((const void*)phase_kernel<6>, hipFuncAttributeMaxDynamicSharedMemorySize, LDS_BYTES);
        hipFuncSetAttribute((const void*)phase_kernel<7>, hipFuncAttributeMaxDynamicSharedMemorySize, LDS_BYTES);
#endif
        (void)hipGetLastError();
        grid = cus > 0 ? cus : 256;
    }
    if (grid < 0) return;
    hipMemsetAsync((char*)d_ws + WS_CTL, 0, CTL_ZERO_BYTES, stream);
    Args a{};
    for (int i = 0; i < 25; ++i) a.in[i] = (const float*)d_in[i];
    a.out = (float*)d_out; a.ws = (unsigned char*)d_ws; a.ph_lo = 0; a.ph_hi = N_PHASES;
#if MEGA
    void* args[] = {&a};
    hipError_t e = hipLaunchCooperativeKernel((const void*)mega_kernel, dim3(grid), dim3(NTHREADS), args, LDS_BYTES, stream);
    if (e != hipSuccess) fprintf(stderr, "cooperative launch failed: %s (grid %d)\n", hipGetErrorString(e), grid);
#else
    hipLaunchKernelGGL(phase_kernel<0>, dim3(grid), dim3(NTHREADS), LDS_BYTES, stream, a);
    hipLaunchKernelGGL(phase_kernel<1>, dim3(grid), dim3(NTHREADS), LDS_BYTES, stream, a);
    hipLaunchKernelGGL(phase_kernel<2>, dim3(grid), dim3(NTHREADS), LDS_BYTES, stream, a);
    hipLaunchKernelGGL(phase_kernel<3>, dim3(grid), dim3(NTHREADS), LDS_BYTES, stream, a);
    hipLaunchKernelGGL(phase_kernel<4>, dim3(grid), dim3(NTHREADS), LDS_BYTES, stream, a);
    hipLaunchKernelGGL(phase_kernel<5>, dim3(grid), dim3(NTHREADS), LDS_BYTES, stream, a);
    hipLaunchKernelGGL(phase_kernel<6>, dim3(grid), dim3(NTHREADS), LDS_BYTES, stream, a);
    hipLaunchKernelGGL(phase_kernel<7>, dim3(grid), dim3(NTHREADS), LDS_BYTES, stream, a);
#endif
}
```
